# Optimizing an MI355X kernel written in HIP

```python
import jax, jax.numpy as jnp
from jax import lax
import numpy as np

D_MODEL = 4096
BATCH = 1
SEQ = 8192
DEPTH = 4

N_META = 16
N_MIXERS = 4
GROUP_W = D_MODEL // N_MIXERS
D_MIX = N_MIXERS * GROUP_W
HEAD_DIM = 128
N_ATTN_HEADS = GROUP_W // HEAD_DIM
BLOCK_Q = 128
CONF_K = 31
SC_K = 3
POOL_WINDOWS = (2, 4, 8, 16)
POOL_GW = GROUP_W // len(POOL_WINDOWS)
N_CHUNKS = 13
D_IN = N_CHUNKS * GROUP_W
EPS = 1e-6

kernel_name = "hymba_parallel_conformer_shortconv_stickbreak_pool"


def rmsnorm(x, g):
    x32 = x.astype(jnp.float32)
    y = x32 * lax.rsqrt(jnp.mean(x32 * x32, axis=-1, keepdims=True) + EPS)
    return (y * g.astype(jnp.float32)).astype(x.dtype)


def layernorm(x, g, b):
    x32 = x.astype(jnp.float32)
    mu = jnp.mean(x32, axis=-1, keepdims=True)
    xc = x32 - mu
    var = jnp.mean(xc * xc, axis=-1, keepdims=True)
    y = xc * lax.rsqrt(var + EPS) * g.astype(jnp.float32) + b.astype(jnp.float32)
    return y.astype(x.dtype)


def causal_dwconv(x, w):
    K, C = w.shape
    return lax.conv_general_dilated(
        x, w[:, None, :].astype(x.dtype), window_strides=(1,),
        padding=[(K - 1, 0)], dimension_numbers=("NWC", "WIO", "NWC"),
        feature_group_count=C)


def stick_breaking_attention(q, k, v, q_g, k_g):
    B_, L, _ = q.shape

    def heads(t):
        return t.reshape(B_, L, N_ATTN_HEADS, HEAD_DIM).transpose(0, 2, 1, 3)

    q = rmsnorm(heads(q), q_g)
    k = rmsnorm(heads(k), k_g)
    v = heads(v)
    pad = (-L) % BLOCK_Q
    padw = ((0, 0), (0, 0), (pad, 0), (0, 0))
    q = jnp.pad(q, padw)
    k = jnp.pad(k, padw)
    v = jnp.pad(v, padw)
    Lp = L + pad
    scale = HEAD_DIM ** -0.5
    outs = []
    for i in range(Lp // BLOCK_Q):
        start, end = i * BLOCK_Q, (i + 1) * BLOCK_Q
        qb = q[:, :, start:end].astype(jnp.float32)
        kb = k[:, :, :end].astype(jnp.float32)
        vb = v[:, :, :end]
        z = jnp.einsum("bhqd,bhkd->bhqk", qb, kb) * scale
        t_pos = jnp.arange(start, end)[:, None]
        s_pos = jnp.arange(end)[None, :]
        mask = (s_pos < t_pos) & (s_pos >= pad)
        log_beta = jax.nn.log_sigmoid(z)
        log_1m_beta = jnp.where(mask, log_beta - z, 0.0)
        tail = lax.cumsum(log_1m_beta, axis=3, reverse=True) - log_1m_beta
        a = jnp.where(mask, jnp.exp(log_beta + tail), 0.0)
        outs.append(jnp.einsum("bhqk,bhkd->bhqd", a.astype(vb.dtype), vb))
    o = jnp.concatenate(outs, axis=2)[:, :, pad:]
    return o.transpose(0, 2, 1, 3).reshape(B_, L, GROUP_W)


def multiscale_pool(x, pool_w, pool_scale):
    B_, L, C = x.shape
    x32 = x.astype(jnp.float32)
    cs = jnp.concatenate([jnp.zeros((B_, 1, C), jnp.float32), jnp.cumsum(x32, axis=1)], axis=1)
    t = jnp.arange(L)
    outs = []
    for gi, w in enumerate(POOL_WINDOWS):
        sl = slice(gi * POOL_GW, (gi + 1) * POOL_GW)
        csg = cs[:, :, sl]
        lo = jnp.maximum(t + 1 - w, 0)
        window_sum = csg[:, 1:] - csg[:, lo]
        count = jnp.minimum(t + 1, w).astype(jnp.float32)[None, :, None]
        pooled = (window_sum / count - x32[:, :, sl]).astype(x.dtype)
        outs.append(pooled @ pool_w[gi])
    return jnp.concatenate(outs, axis=-1) * pool_scale


def hybrid_layer(h, norm_g, w_in, conf_dw_w, conf_dw_b, conf_ln_g, conf_ln_b, conf_pw_w,
                 sc_conv_w, q_norm_g, k_norm_g, pool_w, pool_scale, w_out):
    u = rmsnorm(h, norm_g)
    p = u @ w_in
    (ca, cb, cg, sb, sc, sx, sg, q, k, v, ag, pi, pg) = jnp.split(p, N_CHUNKS, axis=-1)
    a = ca * jax.nn.sigmoid(cb)
    a = causal_dwconv(a, conf_dw_w) + conf_dw_b
    a = jax.nn.silu(layernorm(a, conf_ln_g, conf_ln_b)) @ conf_pw_w
    ya = a * jax.nn.silu(cg)
    yb = sb * causal_dwconv(sc * sx, sc_conv_w) * jax.nn.silu(sg)
    yc = stick_breaking_attention(q, k, v, q_norm_g, k_norm_g) * jax.nn.silu(ag)
    yd = multiscale_pool(pi, pool_w, pool_scale) * jax.nn.silu(pg)
    y = jnp.concatenate([ya, yb, yc, yd], axis=-1) @ w_out
    return h + y


def setup_inputs(seed: int = 0) -> dict:
    key = jax.random.key(seed)
    ks = jax.random.split(key, 16)
    f32 = jnp.float32
    nrm = lambda k, s: jax.random.normal(k, s, f32)
    return {
        "x": nrm(ks[0], (BATCH, SEQ, D_MODEL)),
        "meta_tokens": nrm(ks[1], (N_META, D_MODEL)),
        "norm_g": 1.0 + 0.02 * nrm(ks[2], (DEPTH, D_MODEL)),
        "w_in": nrm(ks[3], (DEPTH, D_MODEL, D_IN)) * D_MODEL ** -0.5,
        "conf_dw_w": nrm(ks[4], (DEPTH, CONF_K, GROUP_W)) * CONF_K ** -0.5,
        "conf_dw_b": 0.02 * nrm(ks[5], (DEPTH, GROUP_W)),
        "conf_ln_g": 1.0 + 0.02 * nrm(ks[6], (DEPTH, GROUP_W)),
        "conf_ln_b": 0.02 * nrm(ks[7], (DEPTH, GROUP_W)),
        "conf_pw_w": nrm(ks[8], (DEPTH, GROUP_W, GROUP_W)) * GROUP_W ** -0.5,
        "sc_conv_w": nrm(ks[9], (DEPTH, SC_K, GROUP_W)) * SC_K ** -0.5,
        "q_norm_g": 1.0 + 0.02 * nrm(ks[10], (DEPTH, HEAD_DIM)),
        "k_norm_g": 1.0 + 0.02 * nrm(ks[11], (DEPTH, HEAD_DIM)),
        "pool_w": nrm(ks[12], (DEPTH, len(POOL_WINDOWS), POOL_GW, POOL_GW)) * POOL_GW ** -0.5,
        "pool_scale": 1.0 + 0.02 * nrm(ks[13], (DEPTH, GROUP_W)),
        "w_out": nrm(ks[14], (DEPTH, D_MIX, D_MODEL)) * D_MIX ** -0.5,
    }


def reference(x, meta_tokens, norm_g, w_in, conf_dw_w, conf_dw_b, conf_ln_g, conf_ln_b,
              conf_pw_w, sc_conv_w, q_norm_g, k_norm_g, pool_w, pool_scale, w_out):
    B_ = x.shape[0]
    meta = jnp.broadcast_to(meta_tokens.astype(x.dtype)[None], (B_, N_META, D_MODEL))
    h = jnp.concatenate([meta, x], axis=1)
    for l in range(DEPTH):
        h = hybrid_layer(h, norm_g[l], w_in[l], conf_dw_w[l], conf_dw_b[l], conf_ln_g[l],
                         conf_ln_b[l], conf_pw_w[l], sc_conv_w[l], q_norm_g[l], k_norm_g[l],
                         pool_w[l], pool_scale[l], w_out[l])
    return h[:, N_META:]
```

```cpp
#include <hip/hip_runtime.h>
#include <cstdio>
#include <cstdint>

#ifndef MK_N_LAUNCHES
#define MK_N_LAUNCHES 1
#endif

namespace pg8 {
#define PG8_LAS __attribute__((address_space(3)))
typedef unsigned short bf16_t;
typedef short bf16x8 __attribute__((ext_vector_type(8)));
typedef float f32x4 __attribute__((ext_vector_type(4)));
typedef unsigned u32x4 __attribute__((ext_vector_type(4)));
constexpr int BM = 256, BK = 64, HALF = 128, HTB = HALF * BK * 2  , STAGE_BYTES = 8 * HTB, NXCD = 8, WGM = 8;

__host__ __device__ __forceinline__ int lds_byte(int r, int c) { const int st = (r >> 4) * 2 + (c >> 5), rr = r & 15, cc = c & 31, ob = rr * 64 + cc * 2; return st * 1024 + (ob ^ (((ob >> 9) & 1) << 5)); }
__host__ __device__ __forceinline__ void stage_rc(int b, int& R, int& C) { const int st = b / 1024, sb = b % 1024, swz = sb ^ (((sb >> 9) & 1) << 5); R = (st >> 1) * 16 + swz / 64; C = (st & 1) * 32 + (swz % 64) / 2; }
__host__ __device__ __forceinline__ int perm32(int rho) { const int n = rho >> 4, i = rho & 15; return 8 * (i >> 2) + 4 * n + (i & 3); }

struct Unit { int pm, pn; };
struct Gemm { const bf16_t* A; const bf16_t* Bt; int M, N, K; };

struct StaticOrder {
    int nM, nN, nwg, G, c;
    __host__ __device__ void init(int M, int N, int G_, int c_) { nM = M / BM; nN = N / BM; nwg = nM * nN; G = G_; c = c_; }
    __host__ __device__ bool next(int i, Unit& u) const {
        const long L = (long)i * G + c; if (L >= nwg) return false;
        int wgid = (int)L; { const int q = nwg / NXCD, r = nwg % NXCD, xcd = wgid % NXCD, off = wgid / NXCD; wgid = (xcd < r ? xcd * (q + 1) : r * (q + 1) + (xcd - r) * q) + off; }
        const int nig = WGM * nN, gid = wgid / nig, fm = gid * WGM, gsz = (nM - fm) < WGM ? (nM - fm) : WGM;
        u.pm = fm + ((wgid % nig) % gsz); u.pn = (wgid % nig) / gsz; return true;
    }
    __device__ __forceinline__ void a_ready(const Unit&) const {}
    __device__ __forceinline__ void done(const Unit&) const {}
};
__device__ __forceinline__ unsigned cvt_pk_bf16(float lo, float hi) { unsigned r; asm("v_cvt_pk_bf16_f32 %0, %1, %2" : "=v"(r) : "v"(lo), "v"(hi)); return r; }
template <class Epi, class Sched, bool ALIGN_EPI = false, bool SP2 = false>
__device__ __forceinline__ void gemm_phase(PG8_LAS unsigned char* lds, const Gemm g, const Sched& S, const Epi& E) {
    int tid_ = threadIdx.x; asm volatile("" : "+v"(tid_));
    const int tid = tid_, wid = __builtin_amdgcn_readfirstlane(tid >> 6), lane = tid & 63, wr = wid >> 2, wc = wid & 3, fr = lane & 15, fq = lane >> 4;
    const int K = g.K, nt = K / BK;
    unsigned voffA[2], voffB[2];
#pragma unroll
    for (int i = 0; i < 2; ++i) { int R, C; stage_rc(tid * 16 + i * 8192, R, C); const int Rb = Epi::PERM ? ((R & ~31) + perm32(R & 31)) : R;
        voffA[i] = (unsigned)(R * K + C) * 2u; voffB[i] = (unsigned)(Rb * K + C) * 2u; }
    const size_t kstep = (size_t)(BK * 2);
    const size_t hstep = (size_t)HALF * K * 2;
    const size_t tstep = 2 * hstep;
    const unsigned ldsw = (unsigned)wid * 1024u;
    const int aoff = lds_byte(wr * 64 + fr, fq * 8), boff = lds_byte(wc * 32 + fr, fq * 8);
#define PG8_SA(b, h) (((b) * 2 + (h)) * HTB)
#define PG8_SB(b, h) ((4 + (b) * 2 + (h)) * HTB)
#define PG8_STAGE(bufoff, gbase, voff) do { _Pragma("unroll") for (int _i = 0; _i < 2; ++_i) \
        __builtin_amdgcn_global_load_lds((const unsigned*)((const char*)(gbase) + (voff)[_i]), (PG8_LAS unsigned*)(lds + (bufoff) + ldsw + _i * 8192), 16, 0, 0); } while (0)
#define PG8_LDA(dst, b, h) do { _Pragma("unroll") for (int m = 0; m < 4; ++m) _Pragma("unroll") for (int k = 0; k < 2; ++k) dst[m][k] = *(const PG8_LAS bf16x8*)(lds + PG8_SA(b, h) + aoff + m * 2048 + k * 1024); } while (0)
#define PG8_LDB(dst, b, h) do { _Pragma("unroll") for (int n = 0; n < 2; ++n) _Pragma("unroll") for (int k = 0; k < 2; ++k) dst[n][k] = *(const PG8_LAS bf16x8*)(lds + PG8_SB(b, h) + boff + n * 2048 + k * 1024); } while (0)
#define PG8_MMA(ai, bj, At, Bt) do { __builtin_amdgcn_s_setprio(1); _Pragma("unroll") for (int m = 0; m < 4; ++m) _Pragma("unroll") for (int n = 0; n < 2; ++n) _Pragma("unroll") for (int k = 0; k < 2; ++k) \
        acc[ai][bj][m][n] = __builtin_amdgcn_mfma_f32_16x16x32_bf16(Bt[n][k], At[m][k], acc[ai][bj][m][n], 0, 0, 0); __builtin_amdgcn_s_setprio(0); } while (0)
#define PG8_WAIT_V(n) asm volatile("s_waitcnt vmcnt(" #n ")" ::: "memory")
#define PG8_WAIT_L(n) asm volatile("s_waitcnt lgkmcnt(" #n ")" ::: "memory")
#define PG8_BAR __builtin_amdgcn_s_barrier()
#define PG8_SCHED __builtin_amdgcn_sched_barrier(0)
    Unit cur, nxt; int ui = 0;
    if (!S.next(0, cur)) return;
    f32x4 acc[2][2][4][2];
#pragma unroll
    for (int a = 0; a < 2; ++a)
#pragma unroll
        for (int b = 0; b < 2; ++b)
#pragma unroll
            for (int m = 0; m < 4; ++m)
#pragma unroll
                for (int n = 0; n < 2; ++n) acc[a][b][m][n] = (f32x4){0.f, 0.f, 0.f, 0.f};
    bf16x8 At[4][2], B0[2][2], B1[2][2];
    const char* cA = (const char*)g.A + (size_t)cur.pm * tstep; const char* cB = (const char*)g.Bt + (size_t)cur.pn * tstep;
    S.a_ready(cur);
    if constexpr (SP2) {
        PG8_STAGE(PG8_SB(0, 0), cB, voffB); PG8_STAGE(PG8_SB(0, 1), cB + hstep, voffB); PG8_STAGE(PG8_SA(0, 0), cA, voffA); PG8_STAGE(PG8_SA(0, 1), cA + hstep, voffA);
        if (wr == 1) PG8_BAR;
        PG8_WAIT_V(2); PG8_BAR;
        PG8_STAGE(PG8_SB(1, 0), cB + kstep, voffB); PG8_STAGE(PG8_SA(1, 0), cA + kstep, voffA); PG8_STAGE(PG8_SB(1, 1), cB + hstep + kstep, voffB);
        PG8_WAIT_V(6); PG8_BAR;
    } else {
        PG8_STAGE(PG8_SB(0, 0), cB, voffB); PG8_STAGE(PG8_SA(0, 0), cA, voffA); PG8_STAGE(PG8_SB(0, 1), cB + hstep, voffB); PG8_STAGE(PG8_SA(0, 1), cA + hstep, voffA);
        if (wr == 1) PG8_BAR;
        PG8_WAIT_V(4); PG8_BAR;
        PG8_STAGE(PG8_SB(1, 0), cB + kstep, voffB); PG8_STAGE(PG8_SA(1, 0), cA + kstep, voffA); PG8_STAGE(PG8_SB(1, 1), cB + hstep + kstep, voffB);
        PG8_WAIT_V(6); PG8_BAR;
    }
    for (;;) {
        const bool has_next = S.next(ui + 1, nxt);
        const char* nA = has_next ? (const char*)g.A + (size_t)nxt.pm * tstep : cA; const char* nB = has_next ? (const char*)g.Bt + (size_t)nxt.pn * tstep : cB;
        for (int t = 0; t < nt; t += 2) {
            const bool last = (t == nt - 2);
            const char* a1 = cA + (size_t)(t + 1) * kstep;
            const char* a2 = last ? nA : cA + (size_t)(t + 2) * kstep; const char* b2 = last ? nB : cB + (size_t)(t + 2) * kstep;
            const char* a3 = a2 + kstep; const char* b3 = b2 + kstep;
            if (last && has_next) S.a_ready(nxt);
            if constexpr (SP2) {
            PG8_LDB(B0, 0, 0); PG8_LDB(B1, 0, 1); PG8_SCHED; PG8_LDA(At, 0, 0); PG8_STAGE(PG8_SA(1, 1), a1 + hstep, voffA);
            PG8_WAIT_V(8); PG8_WAIT_L(0); PG8_BAR; PG8_MMA(0, 0, At, B0); PG8_MMA(0, 1, At, B1); PG8_BAR; PG8_SCHED;
            PG8_LDA(At, 0, 1); PG8_STAGE(PG8_SB(0, 0), b2, voffB); PG8_STAGE(PG8_SB(0, 1), b2 + hstep, voffB); PG8_STAGE(PG8_SA(0, 0), a2, voffA);
            PG8_WAIT_V(8); PG8_WAIT_L(0); PG8_BAR; PG8_MMA(1, 0, At, B0); PG8_MMA(1, 1, At, B1); PG8_BAR; PG8_SCHED;
            PG8_LDB(B0, 1, 0); PG8_LDB(B1, 1, 1); PG8_SCHED; PG8_LDA(At, 1, 0); PG8_STAGE(PG8_SA(0, 1), a2 + hstep, voffA);
            PG8_WAIT_V(8); PG8_WAIT_L(0); PG8_BAR; PG8_MMA(0, 0, At, B0); PG8_MMA(0, 1, At, B1); PG8_BAR; PG8_SCHED;
            PG8_LDA(At, 1, 1); PG8_STAGE(PG8_SB(1, 0), b3, voffB); PG8_STAGE(PG8_SB(1, 1), b3 + hstep, voffB); PG8_STAGE(PG8_SA(1, 0), a3, voffA);
            PG8_WAIT_V(8); PG8_WAIT_L(0); PG8_BAR; PG8_MMA(1, 0, At, B0); PG8_MMA(1, 1, At, B1); PG8_BAR; PG8_SCHED;
            } else {
            PG8_LDB(B0, 0, 0); PG8_SCHED; PG8_LDA(At, 0, 0); PG8_STAGE(PG8_SA(1, 1), a1 + hstep, voffA);
            PG8_WAIT_L(8); PG8_BAR; PG8_WAIT_L(0); PG8_MMA(0, 0, At, B0); PG8_BAR; PG8_SCHED;
            PG8_LDB(B1, 0, 1); PG8_STAGE(PG8_SB(0, 0), b2, voffB);
            PG8_BAR; PG8_WAIT_L(0); PG8_MMA(0, 1, At, B1); PG8_BAR;
            PG8_LDA(At, 0, 1); PG8_STAGE(PG8_SA(0, 0), a2, voffA);
            PG8_BAR; PG8_WAIT_L(0); PG8_MMA(1, 0, At, B0); PG8_BAR; PG8_SCHED;
            PG8_STAGE(PG8_SB(0, 1), b2 + hstep, voffB);
            PG8_WAIT_V(6); PG8_BAR; PG8_MMA(1, 1, At, B1); PG8_BAR;
            PG8_LDB(B0, 1, 0); PG8_SCHED; PG8_LDA(At, 1, 0); PG8_STAGE(PG8_SA(0, 1), a2 + hstep, voffA);
            PG8_WAIT_L(8); PG8_BAR; PG8_WAIT_L(0); PG8_MMA(0, 0, At, B0); PG8_BAR; PG8_SCHED;
            PG8_LDB(B1, 1, 1); PG8_STAGE(PG8_SB(1, 0), b3, voffB);
            PG8_BAR; PG8_WAIT_L(0); PG8_MMA(0, 1, At, B1); PG8_BAR;
            PG8_LDA(At, 1, 1); PG8_STAGE(PG8_SA(1, 0), a3, voffA);
            PG8_BAR; PG8_WAIT_L(0); PG8_MMA(1, 0, At, B0); PG8_BAR; PG8_SCHED;
            PG8_STAGE(PG8_SB(1, 1), b3 + hstep, voffB);
            PG8_WAIT_V(6); PG8_BAR; PG8_MMA(1, 1, At, B1); PG8_BAR;
            }
        }
        if constexpr (ALIGN_EPI) { if (wr == 0) PG8_BAR; }
        if constexpr (!Epi::AFTER_DRAIN) { E(acc, cur, wr, wc, fr, fq); S.done(cur); }
        if (!has_next) break;
#pragma unroll
        for (int a = 0; a < 2; ++a)
#pragma unroll
            for (int b = 0; b < 2; ++b)
#pragma unroll
                for (int m = 0; m < 4; ++m)
#pragma unroll
                    for (int n = 0; n < 2; ++n) acc[a][b][m][n] = (f32x4){0.f, 0.f, 0.f, 0.f};
        cur = nxt; cA = nA; cB = nB; ++ui;
        if constexpr (ALIGN_EPI) { if (wr == 1) PG8_BAR; }
    }
    PG8_WAIT_V(0);
    if constexpr (!ALIGN_EPI) { if (wr == 0) PG8_BAR; }
    PG8_BAR;
    if constexpr (Epi::AFTER_DRAIN) { E.fused(acc, cur, wr, wc, fr, fq, lds, wid, lane); S.done(cur); }
#undef PG8_SA
#undef PG8_SB
#undef PG8_STAGE
#undef PG8_LDA
#undef PG8_LDB
#undef PG8_MMA
#undef PG8_WAIT_V
#undef PG8_WAIT_L
#undef PG8_BAR
#undef PG8_SCHED
}


typedef unsigned u32x2 __attribute__((ext_vector_type(2)));
constexpr int L_TOK = 8208;
constexpr int MPAD  = 8448;
constexpr int DMODEL = 4096, DINP = 13312, GWID = 1024;
constexpr int PW = 10 * 1024;
constexpr size_t PCH = (size_t)MPAD * 1024;
constexpr int PC_GLU = 0, PC_CG = 1, PC_SCSX = 2, PC_GB = 3, PC_Q = 4, PC_K = 5, PC_V = 6, PC_AG = 7, PC_PI = 8, PC_PG = 9;
__host__ __device__ __forceinline__ int win_dst_blk(int srcblk) {
    const int ch = srcblk >> 3, t = srcblk & 7;
    switch (ch) { case 0: return 2 * t; case 1: return 2 * t + 1; case 4: return 16 + 2 * t; case 5: return 17 + 2 * t; case 3: return 32 + 2 * t; case 6: return 33 + 2 * t;
                  case 2: return 48 + t; case 7: return 56 + t; case 8: return 64 + t; case 9: return 72 + t; case 10: return 80 + t; case 11: return 88 + t; default: return 96 + t; }
}

__device__ __forceinline__ float silu_f(float x) { return x * __builtin_amdgcn_rcpf(1.0f + __builtin_amdgcn_exp2f(x * -1.4426950408889634f)); }
__device__ __forceinline__ float sigm_f(float x) { return __builtin_amdgcn_rcpf(1.0f + __builtin_amdgcn_exp2f(x * -1.4426950408889634f)); }
__device__ __forceinline__ float bflo(unsigned u) { return __uint_as_float(u << 16); }
__device__ __forceinline__ float bfhi(unsigned u) { return __uint_as_float(u & 0xffff0000u); }

struct EpiInProj {
    static constexpr bool PERM = true, AFTER_DRAIN = false;
    bf16_t* P; const PG8_LAS float* rtab;
    PG8_LAS float* red;
    const float* qg; const float* kg;
    float qscale;
    __device__ __forceinline__ void operator()(const f32x4 (&acc)[2][2][4][2], const Unit& u, int wr, int wc, int fr, int fq) const {
        const int row0 = u.pm * BM + wr * 64 + fr, pn = u.pn, cin = wc * 32 + 8 * fq;
        const bool qk = (pn >= 28 && pn < 36);
        if (qk) {
#pragma unroll
            for (int ai = 0; ai < 2; ++ai)
#pragma unroll
                for (int m = 0; m < 4; ++m)
#pragma unroll
                    for (int bj = 0; bj < 2; ++bj) { const f32x4 x0 = acc[ai][bj][m][0], x1 = acc[ai][bj][m][1];
                        float s = ((x0[0] * x0[0] + x0[1] * x0[1]) + (x0[2] * x0[2] + x0[3] * x0[3])) + ((x1[0] * x1[0] + x1[1] * x1[1]) + (x1[2] * x1[2] + x1[3] * x1[3]));
                        s += __shfl_xor(s, 16); s += __shfl_xor(s, 32);
                        if (fq == 0) red[(bj * 256 + ai * HALF + wr * 64 + m * 16 + fr) * 4 + wc] = s; }
            asm volatile("s_waitcnt lgkmcnt(0)" ::: "memory"); __builtin_amdgcn_s_barrier(); asm volatile("" ::: "memory");
        }
        int kind, cbase;
        if (pn < 8) { kind = 0; cbase = PC_GLU * 1024 + 128 * pn; } else if (pn < 16) { kind = 1; cbase = PC_SCSX * 1024 + 128 * (pn - 8); } else if (pn < 24) { kind = 2; cbase = PC_GB * 1024 + 128 * (pn - 16); }
        else { const int q = (pn - 24) >> 2, t = (pn - 24) & 3;
            kind = (q == 0 || q == 4 || q == 6) ? 4 : 3;
            const int chunk = (q == 0) ? PC_CG : (q == 1) ? PC_Q : (q == 2) ? PC_K : (q == 3) ? PC_V : (q == 4) ? PC_AG : (q == 5) ? PC_PI : PC_PG;
            cbase = chunk * 1024 + 256 * t; }
#pragma unroll
        for (int ai = 0; ai < 2; ++ai)
#pragma unroll
        for (int mh = 0; mh < 2; ++mh) {
#pragma unroll
            for (int mm = 0; mm < 2; ++mm) {
                const int m = 2 * mh + mm, row = row0 + ai * HALF + m * 16;
                const float rstd = rtab[ai * HALF + wr * 64 + m * 16 + fr];
                bf16_t* rowp = P + (size_t)(cbase >> 10) * PCH + (size_t)row * 1024 + (cbase & 1023) + cin;
                const f32x4 a0 = acc[ai][0][m][0] * rstd, a1 = acc[ai][0][m][1] * rstd, b0 = acc[ai][1][m][0] * rstd, b1 = acc[ai][1][m][1] * rstd;
                if (kind <= 2) {
                    f32x4 r0, r1;
                    if (kind == 0) { for (int e = 0; e < 4; ++e) { r0[e] = a0[e] * sigm_f(b0[e]); r1[e] = a1[e] * sigm_f(b1[e]); } }
                    else if (kind == 1) { r0 = a0 * b0; r1 = a1 * b1; }
                    else { for (int e = 0; e < 4; ++e) { r0[e] = a0[e] * silu_f(b0[e]); r1[e] = a1[e] * silu_f(b1[e]); } }
                    u32x4 w; w.x = cvt_pk_bf16(r0[0], r0[1]); w.y = cvt_pk_bf16(r0[2], r0[3]); w.z = cvt_pk_bf16(r1[0], r1[1]); w.w = cvt_pk_bf16(r1[2], r1[3]);
                    *(u32x4*)rowp = w;
                } else {
                    f32x4 x0 = a0, x1 = a1, y0 = b0, y1 = b1;
                    if (qk) {
                        const int rl = ai * HALF + wr * 64 + m * 16 + fr;
                        const f32x4 sa = *(const PG8_LAS f32x4*)(red + rl * 4), sb = *(const PG8_LAS f32x4*)(red + (256 + rl) * 4);
                        const float r2 = rstd * rstd * (1.0f / 128.0f);
                        float ha = __builtin_amdgcn_rsqf(((sa[0] + sa[1]) + (sa[2] + sa[3])) * r2 + 1e-6f), hb2 = __builtin_amdgcn_rsqf(((sb[0] + sb[1]) + (sb[2] + sb[3])) * r2 + 1e-6f);
                        const float* gp = (pn < 32) ? qg : kg; if (pn < 32) { ha *= qscale; hb2 *= qscale; }
                        const f32x4 g0 = *(const f32x4*)(gp + cin), g1 = *(const f32x4*)(gp + cin + 4);
                        x0 = x0 * g0 * ha; x1 = x1 * g1 * ha; y0 = y0 * g0 * hb2; y1 = y1 * g1 * hb2;
                    }
                    if (kind == 4) { for (int e = 0; e < 4; ++e) { x0[e] = silu_f(x0[e]); x1[e] = silu_f(x1[e]); y0[e] = silu_f(y0[e]); y1[e] = silu_f(y1[e]); } }
                    u32x4 w; w.x = cvt_pk_bf16(x0[0], x0[1]); w.y = cvt_pk_bf16(x0[2], x0[3]); w.z = cvt_pk_bf16(x1[0], x1[1]); w.w = cvt_pk_bf16(x1[2], x1[3]);
                    *(u32x4*)rowp = w;
                    u32x4 v; v.x = cvt_pk_bf16(y0[0], y0[1]); v.y = cvt_pk_bf16(y0[2], y0[3]); v.z = cvt_pk_bf16(y1[0], y1[1]); v.w = cvt_pk_bf16(y1[2], y1[3]);
                    *(u32x4*)(rowp + HALF) = v;
                }
            }
            asm volatile("" ::: "memory");
        }
    }
};

struct EpiOutProj {
    static constexpr bool PERM = true, AFTER_DRAIN = false;
    bf16_t* hb; float* hout; int out_row_off; float* ssq; int last;
    __device__ __forceinline__ void operator()(const f32x4 (&acc)[2][2][4][2], const Unit& u, int wr, int wc, int fr, int fq) const {
        const int row0 = u.pm * BM + wr * 64 + fr, col0 = u.pn * BM + wc * 32 + 8 * fq;
        u32x4 bva[2][4][2];
#pragma unroll
        for (int ai = 0; ai < 2; ++ai)
#pragma unroll
                for (int mm = 0; mm < 4; ++mm) { const int row = row0 + ai * HALF + mm * 16; const int rr = row < L_TOK ? row : 0;
                    const bf16_t* bp = hb + (size_t)rr * DMODEL + col0;
#pragma unroll
                    for (int bj = 0; bj < 2; ++bj) bva[ai][mm][bj] = *(const u32x4*)(bp + bj * HALF); }
#pragma unroll
        for (int ai = 0; ai < 2; ++ai) {
#pragma unroll
                for (int mm = 0; mm < 4; ++mm) {
                    const int m = mm, row = row0 + ai * HALF + m * 16;
                    if (row < L_TOK) {
                        f32x4 o[2][2]; float ss = 0.f;
#pragma unroll
                        for (int bj = 0; bj < 2; ++bj) { const u32x4 b = bva[ai][mm][bj]; const f32x4 a0 = acc[ai][bj][m][0], a1 = acc[ai][bj][m][1];
                            f32x4 q0, q1; q0[0] = bflo(b.x) + a0[0]; q0[1] = bfhi(b.x) + a0[1]; q0[2] = bflo(b.y) + a0[2]; q0[3] = bfhi(b.y) + a0[3];
                            q1[0] = bflo(b.z) + a1[0]; q1[1] = bfhi(b.z) + a1[1]; q1[2] = bflo(b.w) + a1[2]; q1[3] = bfhi(b.w) + a1[3]; o[bj][0] = q0; o[bj][1] = q1;
                            ss += ((q0[0] * q0[0] + q0[1] * q0[1]) + (q0[2] * q0[2] + q0[3] * q0[3])) + ((q1[0] * q1[0] + q1[1] * q1[1]) + (q1[2] * q1[2] + q1[3] * q1[3])); }
                        if (last) {
                            if (row >= out_row_off) { float* op = hout + (size_t)(row - out_row_off) * DMODEL + col0;
#pragma unroll
                                for (int bj = 0; bj < 2; ++bj) { *(f32x4*)(op + bj * HALF) = o[bj][0]; *(f32x4*)(op + bj * HALF + 4) = o[bj][1]; } }
                        } else {
                            bf16_t* hp = hb + (size_t)row * DMODEL + col0;
#pragma unroll
                            for (int bj = 0; bj < 2; ++bj) { u32x4 w; w.x = cvt_pk_bf16(o[bj][0][0], o[bj][0][1]); w.y = cvt_pk_bf16(o[bj][0][2], o[bj][0][3]); w.z = cvt_pk_bf16(o[bj][1][0], o[bj][1][1]); w.w = cvt_pk_bf16(o[bj][1][2], o[bj][1][3]);
                                *(u32x4*)(hp + bj * HALF) = w; }
                            ss += __shfl_xor(ss, 16); ss += __shfl_xor(ss, 32);
                            if (fq == 0) ssq[(size_t)row * 64 + u.pn * 4 + wc] = ss;
                        }
                    }
                }
                asm volatile("" ::: "memory");
            }
    }
};

struct EpiPw {
    static constexpr bool PERM = true, AFTER_DRAIN = false;
    const bf16_t* P; bf16_t* Y;
    __device__ __forceinline__ void operator()(const f32x4 (&acc)[2][2][4][2], const Unit& u, int wr, int wc, int fr, int fq) const {
        const int row0 = u.pm * BM + wr * 64 + fr, col0 = u.pn * BM + wc * 32 + 8 * fq;
        u32x4 gta[2][4][2];
#pragma unroll
        for (int ai = 0; ai < 2; ++ai)
#pragma unroll
            for (int m = 0; m < 4; ++m)
#pragma unroll
                for (int bj = 0; bj < 2; ++bj) gta[ai][m][bj] = *(const u32x4*)(P + PC_CG * PCH + (size_t)(row0 + ai * HALF + m * 16) * 1024 + col0 + bj * HALF);
#pragma unroll
        for (int ai = 0; ai < 2; ++ai) {
#pragma unroll
            for (int m = 0; m < 4; ++m) {
                const int row = row0 + ai * HALF + m * 16;
#pragma unroll
                for (int bj = 0; bj < 2; ++bj) {
                    const u32x4 g4 = gta[ai][m][bj]; const f32x4 a0 = acc[ai][bj][m][0], a1 = acc[ai][bj][m][1];
                    u32x4 w;
                    w.x = cvt_pk_bf16(a0[0] * bflo(g4.x), a0[1] * bfhi(g4.x));
                    w.y = cvt_pk_bf16(a0[2] * bflo(g4.y), a0[3] * bfhi(g4.y));
                    w.z = cvt_pk_bf16(a1[0] * bflo(g4.z), a1[1] * bfhi(g4.z));
                    w.w = cvt_pk_bf16(a1[2] * bflo(g4.w), a1[3] * bfhi(g4.w));
                    *(u32x4*)(Y + (size_t)row * DMODEL + col0 + bj * HALF) = w;
                }
            }
            asm volatile("" ::: "memory");
        }
    }
};

struct EpiPool {
    static constexpr bool PERM = true, AFTER_DRAIN = false;
    const bf16_t* P; bf16_t* Y; const float* pscale;
    __device__ __forceinline__ void operator()(const f32x4 (&acc)[2][2][4][2], const Unit& u, int wr, int wc, int fr, int fq) const {
        const int g = u.pn, pmr = u.pm - 33 * g;
        const int row0 = pmr * BM + wr * 64 + fr, ch0 = 256 * g + wc * 32 + 8 * fq;
#pragma unroll
        for (int ai = 0; ai < 2; ++ai) {
            u32x4 gt[4][2];
#pragma unroll
            for (int m = 0; m < 4; ++m)
#pragma unroll
                for (int bj = 0; bj < 2; ++bj) gt[m][bj] = *(const u32x4*)(P + PC_PG * PCH + (size_t)(row0 + ai * HALF + m * 16) * 1024 + (ch0 & 1023) + bj * HALF);
#pragma unroll
            for (int bj = 0; bj < 2; ++bj) {
                const int ch = ch0 + bj * HALF;
                const f32x4 sc0 = *(const f32x4*)(pscale + ch), sc1 = *(const f32x4*)(pscale + ch + 4);
#pragma unroll
                for (int m = 0; m < 4; ++m) {
                    const int row = row0 + ai * HALF + m * 16;
                    const u32x4 g4 = gt[m][bj]; const f32x4 a0 = acc[ai][bj][m][0] * sc0, a1 = acc[ai][bj][m][1] * sc1;
                    u32x4 w;
                    w.x = cvt_pk_bf16(a0[0] * bflo(g4.x), a0[1] * bfhi(g4.x));
                    w.y = cvt_pk_bf16(a0[2] * bflo(g4.y), a0[3] * bfhi(g4.y));
                    w.z = cvt_pk_bf16(a1[0] * bflo(g4.z), a1[1] * bfhi(g4.z));
                    w.w = cvt_pk_bf16(a1[2] * bflo(g4.w), a1[3] * bfhi(g4.w));
                    *(u32x4*)(Y + (size_t)row * DMODEL + 3 * GWID + ch) = w;
                }
            }
            asm volatile("" ::: "memory");
        }
    }
};
struct PoolOrder {
    int G, c;
    __device__ __forceinline__ bool next(int i, Unit& u) const { const int Lx = i * G + c; if (Lx >= 132) return false; u.pm = Lx; u.pn = Lx / 33; return true; }
    __device__ __forceinline__ void a_ready(const Unit&) const {}
    __device__ __forceinline__ void done(const Unit&) const {}
};
struct XcdOrder {
    int nN, c, inproj, i0;
    __device__ __forceinline__ bool next(int i, Unit& u) const { const int rank = c >> 3, s = 8 * (i + i0) + (rank >> 2); if (s >= nN) return false;
        const int pn = !inproj ? s : (s < 24) ? s : (s < 28) ? s + 20 : (s < 48) ? s - 4 : s; int pm = 4 * (c & 7) + (rank & 3); asm volatile("" : "+s"(pm));
        u.pm = pm; u.pn = pn; return true; }
    __device__ __forceinline__ void a_ready(const Unit&) const {}
    __device__ __forceinline__ void done(const Unit&) const {}
};
}


#define XB_TMO      128
#define XB_XCNT(j)  (256  + 64 * (j))
#define XB_XSUB(j)  (1280 + 64 * (j))
#define XB_XGEN(j)  (2304 + 64 * (j))
#define XB_TOP      3328
#define XB_TOPGEN   3392
#define XCD_BAR_WORDS 3456
#define XB_SPIN_CAP (1u << 18)
#define LAS __attribute__((address_space(3)))

__device__ __forceinline__ unsigned xb_ld(unsigned* p)              { return __hip_atomic_load(p, __ATOMIC_RELAXED, __HIP_MEMORY_SCOPE_AGENT); }
__device__ __forceinline__ unsigned xb_add(unsigned* p, unsigned v) { return __hip_atomic_fetch_add(p, v, __ATOMIC_RELAXED, __HIP_MEMORY_SCOPE_AGENT); }
__device__ __forceinline__ unsigned xb_xcc_id() { return (unsigned)__builtin_amdgcn_s_getreg((3 << 11) | 20) & 0xFu; }
#define XB_SPIN(cond, bar) do { unsigned _sp = 0; while (cond) { __builtin_amdgcn_s_sleep(1); \
    if ((++_sp & 255u) == 0u) { if (xb_ld(&(bar)[XB_TMO])) break; if (_sp > XB_SPIN_CAP) { atomicAdd(&(bar)[XB_TMO], 1u); break; } } } } while (0)

struct XcdBarrier {
    unsigned* bar; unsigned x;
    volatile LAS unsigned* st;
};

__device__ __forceinline__ XcdBarrier xcd_barrier_post(unsigned* bar, volatile LAS unsigned* st) {
    XcdBarrier b; b.bar = bar; b.x = xb_xcc_id(); b.st = st;
    if (threadIdx.x == 0) (void)xb_add(&bar[XB_XCNT(b.x)], 1u);
    return b;
}
__device__ __forceinline__ void xcd_barrier_complete(unsigned* bar, unsigned x, unsigned& nloc, unsigned& nx) {
    const unsigned G = gridDim.x * gridDim.y * gridDim.z;
    unsigned sum, cnt, mine, sp = 0u;
    for (;;) {
        sum = 0u; cnt = 0u; mine = 0u;
#pragma unroll
        for (unsigned j = 0; j < 16; ++j) { const unsigned c = xb_ld(&bar[XB_XCNT(j)]); sum += c; cnt += (c > 0u) ? 1u : 0u; mine = (j == x) ? c : mine; }
        if (sum == G) break;
        __builtin_amdgcn_s_sleep(1);
        if ((++sp & 255u) == 0u) { if (xb_ld(&bar[XB_TMO])) break; if (sp > XB_SPIN_CAP) { atomicAdd(&bar[XB_TMO], 1u); break; } }
    }
    nloc = mine > 0u ? mine : 1u; nx = cnt > 0u ? cnt : 1u;
}

__device__ __forceinline__ void xcd_barrier(const XcdBarrier& b) {
    asm volatile("s_waitcnt vmcnt(0)" ::: "memory");
    __syncthreads();
    if (threadIdx.x == 0) {
        unsigned* bar = b.bar;
        __builtin_amdgcn_s_waitcnt(0);
        unsigned nloc = b.st[0], nx = b.st[1];
        if (nloc == 0u) { xcd_barrier_complete(bar, b.x, nloc, nx); b.st[0] = nloc; b.st[1] = nx; }
        const unsigned old = xb_add(&bar[XB_XSUB(b.x)], 1u);
        const unsigned gen = old / nloc;
        if (old + 1u == (gen + 1u) * nloc) {
            __builtin_amdgcn_fence(__ATOMIC_RELEASE, "agent");
            asm volatile("s_waitcnt vmcnt(0)" ::: "memory");
            const unsigned og = xb_add(&bar[XB_TOP], 1u);
            const unsigned tg = og / nx;
            if (og + 1u == (tg + 1u) * nx) xb_add(&bar[XB_TOPGEN], 1u);
            else XB_SPIN(xb_ld(&bar[XB_TOPGEN]) == tg, bar);
            __builtin_amdgcn_fence(__ATOMIC_ACQUIRE, "agent");
            xb_add(&bar[XB_XGEN(b.x)], 1u);
            asm volatile("s_waitcnt vmcnt(0)" ::: "memory");
        } else {
            XB_SPIN(xb_ld(&bar[XB_XGEN(b.x)]) == gen, bar);
            __builtin_amdgcn_fence(__ATOMIC_ACQUIRE, "agent");
            asm volatile("s_waitcnt vmcnt(0)" ::: "memory");
        }
    }
    __syncthreads();
}

using pg8::bf16_t; using pg8::bf16x8; using pg8::f32x4; using pg8::u32x4; using pg8::u32x2;
using pg8::L_TOK; using pg8::MPAD; using pg8::DMODEL; using pg8::DINP; using pg8::GWID; using pg8::PW; using pg8::PCH;
using pg8::PC_GLU; using pg8::PC_CG; using pg8::PC_SCSX; using pg8::PC_GB; using pg8::PC_Q; using pg8::PC_K; using pg8::PC_V; using pg8::PC_AG; using pg8::PC_PI; using pg8::PC_PG;
using pg8::silu_f; using pg8::sigm_f; using pg8::bflo; using pg8::bfhi; using pg8::cvt_pk_bf16;
typedef float f32x16 __attribute__((ext_vector_type(16)));
typedef short s16x4 __attribute__((ext_vector_type(4)));

constexpr int NTHR = 512, NLAYER = 4;
constexpr int LDS_BYTES = 147456, MISC_OFF = 131072;
constexpr int MISC_Q = 4, MISC_DONE = 5;
constexpr int MISC_STAT = 256, MISC_FIN = 2560;

constexpr size_t AL256(size_t x) { return (x + 255) & ~(size_t)255; }
constexpr size_t WS_CTL = 0;
constexpr size_t CTL_BYTES = 65536;
constexpr size_t SZ_WIN_L = (size_t)DINP * DMODEL * 2, SZ_WOUT_L = (size_t)DMODEL * DMODEL * 2, SZ_WPW_L = (size_t)GWID * GWID * 2, SZ_WPOOL_L = (size_t)4 * 256 * 256 * 2;
constexpr size_t WS_WIN = WS_CTL + CTL_BYTES;
constexpr size_t WS_WOUT = WS_WIN + NLAYER * SZ_WIN_L;
constexpr size_t WS_WPW = WS_WOUT + NLAYER * SZ_WOUT_L;
constexpr size_t WS_WPOOL = WS_WPW + NLAYER * SZ_WPW_L;
constexpr size_t WS_H = WS_WPOOL + NLAYER * SZ_WPOOL_L;
constexpr size_t WS_HB = WS_H + (size_t)MPAD * DMODEL * 4;
constexpr size_t WS_SSQ = WS_HB + (size_t)MPAD * DMODEL * 2;
constexpr size_t WS_SSQT = WS_SSQ + (size_t)MPAD * 64 * 4;
constexpr size_t WS_P = WS_SSQT + 16 * 256 * 4;
constexpr size_t WS_ALN = WS_P + (size_t)MPAD * DINP * 2;
constexpr size_t WS_QN = WS_ALN + (size_t)MPAD * GWID * 2;
constexpr size_t WS_KN = WS_QN + (size_t)MPAD * GWID * 2;
constexpr size_t WS_POOLED = WS_KN + (size_t)MPAD * GWID * 2;
constexpr size_t WS_YCAT = WS_POOLED + (size_t)MPAD * GWID * 2;
constexpr size_t WS_END = WS_YCAT + (size_t)MPAD * DMODEL * 2;
constexpr int CW_BAR = 0;
constexpr int CW_QUEUE = 4096;
constexpr int CW_PREPQ = 8192, CW_RDY = 8704, CW_THIN = 9216;

__device__ __forceinline__ float wave_sum(float v) {
#pragma unroll
    for (int o = 32; o >= 1; o >>= 1) v += __shfl_xor(v, o);
    return v;
}

struct Args { const float* in[15]; float* out; unsigned char* ws; int ph_lo, ph_hi; };
typedef const __attribute__((address_space(4))) Args* KArgP;
struct Frame {
    LAS unsigned char* lds; volatile LAS unsigned* misc; int tid, lane, wave, G; KArgP kp;
    __device__ __forceinline__ void refresh() { int t = threadIdx.x; asm volatile("" : "+v"(t)); tid = t; lane = t & 63; wave = __builtin_amdgcn_readfirstlane(t >> 6); }
};
__device__ __forceinline__ KArgP kargs(const Frame& F) { KArgP p = F.kp; asm volatile("" : "+s"(p)); return p; }
#define KIN(i) (kargs(F)->in[i])
#define KWS (kargs(F)->ws)
#define KCTL ((unsigned*)(kargs(F)->ws + WS_CTL))

constexpr int CU_IN = 32 * 52, CU_OUT = 32 * 16, CU_PW = 8 * 4, CU_POOL = 4 * 2, CU_L = CU_IN + CU_OUT + CU_PW + CU_POOL;
struct TrJob { const float* src; const float* scale; bf16_t* dst; int K, N, k0, n0, perm; };
__device__ __forceinline__ TrJob tr_decode(const Frame& F, int l, int r) {
    TrJob j; j.scale = nullptr; j.perm = 0;
    if (r < CU_IN) { j.perm = 1; j.src = KIN(3) + (size_t)l * DMODEL * DINP; j.scale = KIN(2) + l * DMODEL; j.dst = (bf16_t*)(KWS + WS_WIN + l * SZ_WIN_L); j.K = DMODEL; j.N = DINP; j.k0 = (r / 104) * 256; j.n0 = (r % 104) * 128; }
    else if (r < CU_IN + CU_OUT) { r -= CU_IN; j.src = KIN(14) + (size_t)l * DMODEL * DMODEL; j.dst = (bf16_t*)(KWS + WS_WOUT + l * SZ_WOUT_L); j.K = DMODEL; j.N = DMODEL; j.k0 = (r / 32) * 256; j.n0 = (r % 32) * 128; }
    else if (r < CU_IN + CU_OUT + CU_PW) { r -= CU_IN + CU_OUT; j.src = KIN(8) + (size_t)l * GWID * GWID; j.dst = (bf16_t*)(KWS + WS_WPW + l * SZ_WPW_L); j.K = GWID; j.N = GWID; j.k0 = (r / 8) * 256; j.n0 = (r % 8) * 128; }
    else { r -= CU_IN + CU_OUT + CU_PW; const int g = r >> 1; j.src = KIN(12) + (size_t)(l * 4 + g) * 65536; j.dst = (bf16_t*)(KWS + WS_WPOOL + l * SZ_WPOOL_L) + (size_t)g * 65536; j.K = 256; j.N = 256; j.k0 = 0; j.n0 = (r & 1) * 128; }
    return j;
}
template <bool NT> __device__ __forceinline__ f32x4 ldg4(const float* p) { if (NT) return __builtin_nontemporal_load((const f32x4*)p); else return *(const f32x4*)p; }
template <bool NT> __device__ __forceinline__ void stg4(bf16_t* p, u32x4 v) { if (NT) __builtin_nontemporal_store(v, (u32x4*)p); else *(u32x4*)p = v; }
__device__ __forceinline__ void conv_issue(const Frame& F, int l, int r, int lane, int wave, f32x4 (&Rx)[4][2][2], float (&Rsc)[4][2]) {
    const TrJob j = tr_decode(F, l, r);
    const int i = lane & 15, g = lane >> 4, krow = 8 * (i >> 2) + (i & 3);
    const float* sp = j.src + (size_t)(j.k0 + 128 * (wave >> 2) + krow) * j.N + j.n0 + 32 * (wave & 3) + 4 * g;
#pragma unroll
    for (int kb = 0; kb < 4; ++kb)
#pragma unroll
        for (int h = 0; h < 2; ++h) { const float* p = sp + (size_t)(32 * kb + 4 * h) * j.N; Rx[kb][h][0] = *(const f32x4*)p; Rx[kb][h][1] = *(const f32x4*)(p + 16);
            Rsc[kb][h] = j.scale ? j.scale[j.k0 + 128 * (wave >> 2) + krow + 32 * kb + 4 * h] : 1.0f; }
}
__device__ __forceinline__ void conv_finish(const Frame& F, int l, int r, int lane, int wave, const f32x4 (&Rx)[4][2][2], const float (&Rsc)[4][2]) {
    const TrJob j = tr_decode(F, l, r);
    const int i = lane & 15, g = lane >> 4;
    u32x4 b0 = {0u, 0u, 0u, 0u}, b1 = {0u, 0u, 0u, 0u};
    { const int e = i - 4 * g;
      if (e >= 0 && e < 4) { const unsigned one = (e & 1) ? 0x3F800000u : 0x00003F80u; if (e < 2) { b0.x = one; b1.z = one; } else { b0.y = one; b1.w = one; } } }
    const bf16x8 B0 = *reinterpret_cast<const bf16x8*>(&b0), B1 = *reinterpret_cast<const bf16x8*>(&b1);
    const int nsrc = j.n0 + 32 * (wave & 3), ndst = j.perm ? pg8::win_dst_blk(nsrc >> 7) * 128 + (nsrc & 127) : nsrc;
    bf16_t* dp = j.dst + (size_t)(ndst + i) * j.K + j.k0 + 128 * (wave >> 2) + 8 * g;
#pragma unroll
    for (int kb = 0; kb < 4; ++kb) {
        bf16x8 A[2];
#pragma unroll
        for (int h = 0; h < 2; ++h) { const f32x4 lo = Rx[kb][h][0] * Rsc[kb][h], hi = Rx[kb][h][1] * Rsc[kb][h];
            u32x4 w; w.x = cvt_pk_bf16(lo[0], lo[1]); w.y = cvt_pk_bf16(lo[2], lo[3]); w.z = cvt_pk_bf16(hi[0], hi[1]); w.w = cvt_pk_bf16(hi[2], hi[3]);
            A[h] = *reinterpret_cast<const bf16x8*>(&w); }
        const f32x4 z = {0.f, 0.f, 0.f, 0.f};
        const f32x4 c00 = __builtin_amdgcn_mfma_f32_16x16x32_bf16(A[0], B0, z, 0, 0, 0), c10 = __builtin_amdgcn_mfma_f32_16x16x32_bf16(A[1], B0, z, 0, 0, 0);
        const f32x4 c01 = __builtin_amdgcn_mfma_f32_16x16x32_bf16(A[0], B1, z, 0, 0, 0), c11 = __builtin_amdgcn_mfma_f32_16x16x32_bf16(A[1], B1, z, 0, 0, 0);
        u32x4 w0, w1;
#define PK2(lo, hi) __builtin_amdgcn_perm(__float_as_uint(hi), __float_as_uint(lo), 0x07060302u)
        w0.x = PK2(c00[0], c00[1]); w0.y = PK2(c00[2], c00[3]); w0.z = PK2(c10[0], c10[1]); w0.w = PK2(c10[2], c10[3]);
        w1.x = PK2(c01[0], c01[1]); w1.y = PK2(c01[2], c01[3]); w1.z = PK2(c11[0], c11[1]); w1.w = PK2(c11[2], c11[3]);
#undef PK2
        *(u32x4*)(dp + 32 * kb) = w0; *(u32x4*)(dp + (size_t)16 * j.K + 32 * kb) = w1;
    }
}
template <bool NT> __device__ __forceinline__ void convert_units(const Frame& F0, int l, int first, int stride, int count) {
    if (count <= 0) return;
    Frame F = F0; F.refresh();
    const int lane = F.lane, wave = F.wave;
    f32x4 xa[4][2][2]; float sa[4][2]; f32x4 xb[4][2][2]; float sb[4][2];
    conv_issue(F, l, first, lane, wave, xa, sa);
    int k = 0;
#pragma unroll 1
    while (k + 2 < count) {
        conv_issue(F, l, first + stride * (k + 1), lane, wave, xb, sb);
        conv_finish(F, l, first + stride * k, lane, wave, xa, sa);
        conv_issue(F, l, first + stride * (k + 2), lane, wave, xa, sa);
        conv_finish(F, l, first + stride * (k + 1), lane, wave, xb, sb);
        k += 2;
    }
    if (count - k == 2) {
        conv_issue(F, l, first + stride * (k + 1), lane, wave, xb, sb);
        conv_finish(F, l, first + stride * k, lane, wave, xa, sa);
        conv_finish(F, l, first + stride * (k + 1), lane, wave, xb, sb);
    } else conv_finish(F, l, first + stride * k, lane, wave, xa, sa);
}
__device__ __forceinline__ void p0_prologue(const Frame& F0) {
    Frame F = F0; F.refresh();
    convert_units<false>(F, 0, (int)blockIdx.x, F.G, (CU_L - (int)blockIdx.x + F.G - 1) / F.G);
    {
        const float* x = KIN(0); const float* meta = KIN(1);
        bf16_t* HB = (bf16_t*)(KWS + WS_HB); float* SSQ = (float*)(KWS + WS_SSQ);
        for (int r = blockIdx.x * 8 + F.wave; r < MPAD; r += F.G * 8) {
            float ss = 0.f;
            if (r < L_TOK) {
                const float* src = r < 16 ? meta + (size_t)r * DMODEL : x + (size_t)(r - 16) * DMODEL;
#pragma unroll 4
                for (int i = 0; i < 16; ++i) { const int c = 4 * (F.lane + 64 * i); const f32x4 vv = *(const f32x4*)(src + c);
                    ss += (vv[0] * vv[0] + vv[1] * vv[1]) + (vv[2] * vv[2] + vv[3] * vv[3]);
                    u32x2 w; w.x = cvt_pk_bf16(vv[0], vv[1]); w.y = cvt_pk_bf16(vv[2], vv[3]); *(u32x2*)(HB + (size_t)r * DMODEL + c) = w; }
                ss = wave_sum(ss);
            } else {
#pragma unroll 4
                for (int i = 0; i < 16; ++i) { const int c = 4 * (F.lane + 64 * i);
                    u32x2 w; w.x = 0u; w.y = 0u; *(u32x2*)(HB + (size_t)r * DMODEL + c) = w; }
            }
            SSQ[(size_t)r * 64 + F.lane] = (F.lane == 0) ? ss : 0.f;
            if (r >= 8192 && r < 8208) { float* T = (float*)(KWS + WS_SSQT) + (r - 8192) * 256;
#pragma unroll
                for (int i = 0; i < 4; ++i) T[F.lane + 64 * i] = (F.lane == 0 && i == 0) ? ss : 0.f; }
        }
    }
}

constexpr int PT = 34, PH = 17, PSTRIDE = 33, PREP_TILES = (MPAD + PSTRIDE - 1) / PSTRIDE;
constexpr float QSCALE = 0.08838834764831845f * 1.4426950408889634f;
constexpr int RW = PW / 2;
__device__ __forceinline__ int clampt(int t) { return t < 0 ? 0 : (t > MPAD - 1 ? MPAD - 1 : t); }
template <int W> __device__ __forceinline__ void pool_part(const unsigned* xp, unsigned* op, int t0) {
    unsigned xs[PT + W - 1];
#pragma unroll
    for (int i = 0; i < PT + W - 1; ++i) xs[i] = xp[(size_t)clampt(t0 - (W - 1) + i) * 512];
    float S0 = 0.f, S1 = 0.f;
#pragma unroll
    for (int i = 0; i < W - 1; ++i) { if (t0 - (W - 1) + i >= 0) { S0 += bflo(xs[i]); S1 += bfhi(xs[i]); } }
#pragma unroll
    for (int j = 0; j < PT; ++j) { const int t = t0 + j; const float x0 = bflo(xs[W - 1 + j]), x1 = bfhi(xs[W - 1 + j]);
        S0 += x0; S1 += x1;
        const int cnt = (t + 1 < W) ? (t + 1) : W; const float ic = 1.0f / (float)cnt;
        if (t < MPAD && j < PSTRIDE) op[(size_t)j * 128] = cvt_pk_bf16(S0 * ic - x0, S1 * ic - x1);
        if (t - W + 1 >= 0) { S0 -= bflo(xs[j]); S1 -= bfhi(xs[j]); } }
}
__device__ __forceinline__ void prep_tile(const Frame& F0, int l, int tile_in) {
    Frame F = F0; F.refresh();
    const int tile = __builtin_amdgcn_readfirstlane(tile_in);
    const int tid = F.tid, lane = F.lane, wave = F.wave;
    unsigned char* const ws = KWS;
    const unsigned* P32 = (const unsigned*)(ws + WS_P);
    LAS unsigned* glu = (LAS unsigned*)F.lds;
    LAS float* stat = (LAS float*)(F.lds + MISC_OFF + MISC_STAT);
    LAS float* fin = (LAS float*)(F.lds + MISC_OFF + MISC_FIN);
    {
        const int t0 = tile * PSTRIDE;
#pragma unroll 1
        for (int rb = 0; rb < 4; ++rb) {
            unsigned ca[16];
#pragma unroll
            for (int i = 0; i < 16; ++i) ca[i] = P32[((size_t)PC_GLU * MPAD + clampt(t0 - 30 + 16 * rb + i)) * 512 + tid];
#pragma unroll
            for (int i = 0; i < 16; ++i) { const int t = t0 - 30 + 16 * rb + i;
                glu[(16 * rb + i) * 512 + tid] = (t < 0 || t >= MPAD) ? 0u : ca[i]; }
        }
        __syncthreads();
        {
            const float* dw = KIN(4) + (size_t)l * 31 * GWID + 2 * tid;
            float w[31][2];
#pragma unroll
            for (int k = 0; k < 31; ++k) { const float2 ww = *(const float2*)(dw + k * GWID); w[k][0] = ww.x; w[k][1] = ww.y; }
            const float2 cb2 = *(const float2*)(KIN(5) + l * GWID + 2 * tid);
            const float2 gg = *(const float2*)(KIN(6) + l * GWID + 2 * tid), bb = *(const float2*)(KIN(7) + l * GWID + 2 * tid);
            unsigned* alnp = (unsigned*)(ws + WS_ALN) + (size_t)t0 * 512 + tid;
#pragma unroll 1
            for (int blk = 0; blk < 2; ++blk) {
                float acc[PH][2];
#pragma unroll
                for (int j = 0; j < PH; ++j) { acc[j][0] = cb2.x; acc[j][1] = cb2.y; }
                const LAS unsigned* gb = glu + (PH * blk) * 512 + tid;
#pragma unroll
                for (int r = 0; r < PH + 30; ++r) { const unsigned u = gb[r * 512]; const float g0 = bflo(u), g1 = bfhi(u);
#pragma unroll
                    for (int j = 0; j < PH; ++j) { const int k = r - j; if (k >= 0 && k <= 30) { acc[j][0] = fmaf(w[k][0], g0, acc[j][0]); acc[j][1] = fmaf(w[k][1], g1, acc[j][1]); } } }
#pragma unroll
                for (int j = 0; j < PH; ++j) { const float s1 = wave_sum(acc[j][0] + acc[j][1]), s2 = wave_sum(acc[j][0] * acc[j][0] + acc[j][1] * acc[j][1]);
                    if (lane == 0) { stat[(j * 8 + wave) * 2] = s1; stat[(j * 8 + wave) * 2 + 1] = s2; } }
                __syncthreads();
                if (tid < PH) { float s1 = 0.f, s2 = 0.f;
#pragma unroll
                    for (int wv = 0; wv < 8; ++wv) { s1 += stat[(tid * 8 + wv) * 2]; s2 += stat[(tid * 8 + wv) * 2 + 1]; }
                    const float mean = s1 * (1.0f / 1024.0f), var = fmaxf(s2 * (1.0f / 1024.0f) - mean * mean, 0.f);
                    fin[tid * 2] = mean; fin[tid * 2 + 1] = __builtin_amdgcn_rsqf(var + 1e-6f); }
                __syncthreads();
#pragma unroll
                for (int j = 0; j < PH; ++j) { const int t = t0 + PH * blk + j; const float mean = fin[j * 2], rs = fin[j * 2 + 1];
                    const float y0 = (acc[j][0] - mean) * rs * gg.x + bb.x, y1 = (acc[j][1] - mean) * rs * gg.y + bb.y;
                    if (t < MPAD && PH * blk + j < PSTRIDE) alnp[(size_t)(PH * blk + j) * 512] = cvt_pk_bf16(silu_f(y0), silu_f(y1)); }
            }
        }
        {
            const float* scw = KIN(9) + (size_t)l * 3 * GWID + 2 * tid;
            const float2 w0 = *(const float2*)(scw), w1 = *(const float2*)(scw + GWID), w2 = *(const float2*)(scw + 2 * GWID);
            unsigned* yp = (unsigned*)(ws + WS_YCAT) + (size_t)t0 * (DMODEL / 2) + 512 + tid;
#pragma unroll 1
            for (int hf = 0; hf < 2; ++hf) {
                const int tb = t0 + PH * hf;
                unsigned usc[PH + 2], usb[PH];
#pragma unroll
                for (int i = 0; i < PH + 2; ++i) usc[i] = P32[((size_t)PC_SCSX * MPAD + clampt(tb - 2 + i)) * 512 + tid];
#pragma unroll
                for (int i = 0; i < PH; ++i) usb[i] = P32[((size_t)PC_GB * MPAD + clampt(tb + i)) * 512 + tid];
                float pr[PH + 2][2];
#pragma unroll
                for (int i = 0; i < PH + 2; ++i) { const bool ok = (tb - 2 + i >= 0); pr[i][0] = ok ? bflo(usc[i]) : 0.f; pr[i][1] = ok ? bfhi(usc[i]) : 0.f; }
#pragma unroll
                for (int i = 0; i < PH; ++i) {
                    const float cv0 = w0.x * pr[i][0] + w1.x * pr[i + 1][0] + w2.x * pr[i + 2][0], cv1 = w0.y * pr[i][1] + w1.y * pr[i + 1][1] + w2.y * pr[i + 2][1];
                    if (tb + i < MPAD && PH * hf + i < PSTRIDE) yp[(size_t)(PH * hf + i) * (DMODEL / 2)] = cvt_pk_bf16(bflo(usb[i]) * cv0, bfhi(usb[i]) * cv1); }
            }
        }
        {
            const int gi = __builtin_amdgcn_readfirstlane(tid >> 7);
            const unsigned* xp = P32 + (size_t)PC_PI * MPAD * 512 + tid;
            unsigned* op = (unsigned*)(ws + WS_POOLED) + ((size_t)gi * MPAD + t0) * 128 + (tid & 127);
            if (gi == 0) pool_part<2>(xp, op, t0); else if (gi == 1) pool_part<4>(xp, op, t0); else if (gi == 2) pool_part<8>(xp, op, t0); else pool_part<16>(xp, op, t0);
        }
        __syncthreads();
    }
}

__device__ __forceinline__ void publish_add(unsigned* ctr) {
    asm volatile("s_waitcnt vmcnt(0)" ::: "memory");
    __syncthreads();
    if (threadIdx.x == 0) {
        __builtin_amdgcn_fence(__ATOMIC_RELEASE, "agent");
        asm volatile("s_waitcnt vmcnt(0)" ::: "memory");
        (void)xb_add(ctr, 1u);
    }
}
__device__ __forceinline__ void wait_count(const Frame& F, unsigned* ctr, unsigned need) {
    if (threadIdx.x == 0) {
        unsigned* bar = KCTL + CW_BAR;
        XB_SPIN(xb_ld(ctr) < need, bar);
        __builtin_amdgcn_fence(__ATOMIC_ACQUIRE, "agent");
        asm volatile("s_waitcnt vmcnt(0)" ::: "memory");
    }
    __syncthreads();
}
__device__ __forceinline__ void prep_queue(const Frame& F0, int l) {
    Frame F = F0; F.refresh();
    unsigned* head = KCTL + CW_PREPQ + 64 * l;
    bool got_main = false, got_thin = false;
    for (;;) {
        if (F.tid == 0) F.misc[MISC_Q] = __hip_atomic_fetch_add(head, 1u, __ATOMIC_RELAXED, __HIP_MEMORY_SCOPE_AGENT);
        __syncthreads();
        const unsigned u = F.misc[MISC_Q];
        __syncthreads();
        if (u >= (unsigned)PREP_TILES) break;
        if (!got_main) { wait_count(F, KCTL + CW_RDY + 64 * l, (unsigned)F.G); got_main = true; }
        if (!got_thin && (int)u * PSTRIDE + PSTRIDE >= 8192) { wait_count(F, KCTL + CW_THIN + 64 * l, 104u); got_thin = true; }
        prep_tile(F, l, (int)u);
    }
}

#ifndef ATTN_EARLY_EXIT
#define ATTN_EARLY_EXIT 1
#endif
constexpr int A_KBUF = 16384, A_VSTRIDE = 320, A_VBUF = 64 * A_VSTRIDE, A_VOFF = 2 * A_KBUF;
#define KSWZ(row, colB) ((row) * 256 + ((colB) ^ (((row) & 7) << 4)))
template <int OFF> __device__ __forceinline__ s16x4 tr_read(unsigned vb) {
    s16x4 r; asm volatile("ds_read_b64_tr_b16 %0, %1 offset:%2" : "=&v"(r) : "v"(vb), "i"(OFF) : "memory"); return r;
}
__device__ __forceinline__ int crow(int r, int hi) { return (r & 3) + 8 * (r >> 2) + 4 * hi; }

template <int SBLK>
__device__ __forceinline__ void sb_block(const f32x16& pz, f32x16 (&o)[4], float& Cw, const int hi, const unsigned vb) {
    float sg[16], om[16];
#pragma unroll
    for (int r = 0; r < 16; ++r) { const float z = pz[r];
        const float e = __builtin_amdgcn_exp2f(-z), rc = __builtin_amdgcn_rcpf(1.0f + e); sg[r] = rc; om[r] = e * rc; }
    float a[16];
#pragma unroll
    for (int i = 3; i >= 0; --i) {
        const float x2 = om[4 * i + 3], x1 = x2 * om[4 * i + 2], x0 = x1 * om[4 * i + 1], R = x0 * om[4 * i];
        const auto rr = __builtin_amdgcn_permlane32_swap(__float_as_uint(R), __float_as_uint(R), false, false);
        const float R0 = __uint_as_float(rr[0]), R1 = __uint_as_float(rr[1]);
        const float base = hi ? Cw : Cw * R1;
        a[4 * i + 3] = sg[4 * i + 3] * base; a[4 * i + 2] = sg[4 * i + 2] * (base * x2); a[4 * i + 1] = sg[4 * i + 1] * (base * x1); a[4 * i] = sg[4 * i] * (base * x0);
        Cw = Cw * (R0 * R1);
    }
    u32x4 w0, w1;
    w0.x = cvt_pk_bf16(a[0], a[1]); w0.y = cvt_pk_bf16(a[2], a[3]); w0.z = cvt_pk_bf16(a[4], a[5]); w0.w = cvt_pk_bf16(a[6], a[7]);
    w1.x = cvt_pk_bf16(a[8], a[9]); w1.y = cvt_pk_bf16(a[10], a[11]); w1.z = cvt_pk_bf16(a[12], a[13]); w1.w = cvt_pk_bf16(a[14], a[15]);
    const bf16x8 pf0 = *reinterpret_cast<const bf16x8*>(&w0), pf1 = *reinterpret_cast<const bf16x8*>(&w1);
#define PVBLK(DB) do { \
        const s16x4 l0 = tr_read<(32 * SBLK + 0) * A_VSTRIDE + 64 * (DB)>(vb), h0 = tr_read<(32 * SBLK + 8) * A_VSTRIDE + 64 * (DB)>(vb); \
        const s16x4 l1 = tr_read<(32 * SBLK + 16) * A_VSTRIDE + 64 * (DB)>(vb), h1 = tr_read<(32 * SBLK + 24) * A_VSTRIDE + 64 * (DB)>(vb); \
        asm volatile("s_waitcnt lgkmcnt(0)" ::: "memory"); __builtin_amdgcn_sched_barrier(0); \
        o[DB] = __builtin_amdgcn_mfma_f32_32x32x16_bf16((bf16x8){l0[0], l0[1], l0[2], l0[3], h0[0], h0[1], h0[2], h0[3]}, pf0, o[DB], 0, 0, 0); \
        o[DB] = __builtin_amdgcn_mfma_f32_32x32x16_bf16((bf16x8){l1[0], l1[1], l1[2], l1[3], h1[0], h1[1], h1[2], h1[3]}, pf1, o[DB], 0, 0, 0); } while (0)
    PVBLK(0); PVBLK(1); PVBLK(2); PVBLK(3);
#undef PVBLK
}

__device__ __forceinline__ void attn_unit(const Frame& F, int hd, int qstart, int nq) {
    const int tid = F.tid, wid = F.wave, lane = F.lane, r32 = lane & 31, hi = lane >> 5;
    LAS unsigned char* lds = F.lds;
    const bf16_t* Qh = (const bf16_t*)(KWS + WS_P) + PC_Q * PCH + hd * 128; const bf16_t* Kh = (const bf16_t*)(KWS + WS_P) + PC_K * PCH + hd * 128;
    const bf16_t* Pm = (const bf16_t*)(KWS + WS_P); const bf16_t* Vh = Pm + PC_V * PCH + hd * 128;
    bf16_t* Y = (bf16_t*)(KWS + WS_YCAT);
    const int qend = qstart + nq;
    const int q0w = qstart + 32 * wid, myq = q0w + r32;
    bf16x8 qr[8];
    { const bf16_t* qp = Qh + (size_t)myq * GWID + hi * 8;
#pragma unroll
      for (int d0 = 0; d0 < 8; ++d0) qr[d0] = *(const bf16x8*)(qp + d0 * 16); }
    f32x16 o[4];
#pragma unroll
    for (int d = 0; d < 4; ++d)
#pragma unroll
        for (int r = 0; r < 16; ++r) o[d][r] = 0.f;
    float Cw = 1.0f;
    const int jt_hi = (qstart + nq - 2) >> 6;
    const int sr = tid >> 4, sc = (tid & 15) * 8;
    const unsigned vbase = (unsigned)(size_t)(lds + A_VOFF) + (unsigned)((4 * hi + ((lane & 15) >> 2)) * A_VSTRIDE + (16 * ((lane >> 4) & 1) + 4 * (lane & 3)) * 2);
    u32x4 gk0, gk1, gv0, gv1;
#define ALOAD(jt) do { const size_t kr = (size_t)(64 * (jt) + sr); \
        gk0 = *(const u32x4*)(Kh + kr * GWID + sc); gk1 = *(const u32x4*)(Kh + (kr + 32) * GWID + sc); \
        gv0 = *(const u32x4*)(Vh + kr * GWID + sc); gv1 = *(const u32x4*)(Vh + (kr + 32) * GWID + sc); } while (0)
#define AWRITE(b) do { *(LAS u32x4*)(lds + (b) * A_KBUF + KSWZ(sr, sc * 2)) = gk0; *(LAS u32x4*)(lds + (b) * A_KBUF + KSWZ(sr + 32, sc * 2)) = gk1; \
        *(LAS u32x4*)(lds + A_VOFF + (b) * A_VBUF + sr * A_VSTRIDE + sc * 2) = gv0; *(LAS u32x4*)(lds + A_VOFF + (b) * A_VBUF + (sr + 32) * A_VSTRIDE + sc * 2) = gv1; } while (0)
    if (tid == 0) F.misc[MISC_DONE] = (unsigned)(8 - ((nq + 31) >> 5));
    ALOAD(jt_hi); AWRITE(0);
    __syncthreads();
    bool wdone = (32 * wid >= nq);
    for (int it = 0;; ++it) {
        const int jt = jt_hi - it, cur = it & 1; const bool more = jt > 0;
        if (more) ALOAD(jt - 1);
        const int tlo = 64 * jt;
        if (!wdone && tlo <= q0w + 30) {
            const bool need_mask = (tlo + 63 >= q0w);
            const LAS unsigned char* Kb = lds + cur * A_KBUF;
            f32x16 p0, p1;
#pragma unroll
            for (int r = 0; r < 16; ++r) { p0[r] = 0.f; p1[r] = 0.f; }
#pragma unroll
            for (int d0 = 0; d0 < 8; ++d0) { const int cb = (d0 * 16 + hi * 8) * 2;
                const bf16x8 b0 = *(const LAS bf16x8*)(Kb + KSWZ(r32, cb)), b1 = *(const LAS bf16x8*)(Kb + KSWZ(32 + r32, cb));
                p0 = __builtin_amdgcn_mfma_f32_32x32x16_bf16(b0, qr[d0], p0, 0, 0, 0);
                p1 = __builtin_amdgcn_mfma_f32_32x32x16_bf16(b1, qr[d0], p1, 0, 0, 0); }
            const unsigned vb = vbase + (unsigned)(cur * A_VBUF);
            if (need_mask) {
#pragma unroll
                for (int r = 0; r < 16; ++r) { const int key = tlo + crow(r, hi); p0[r] = (key < myq) ? p0[r] : -120.f; p1[r] = (key + 32 < myq) ? p1[r] : -120.f; }
            }
            sb_block<1>(p1, o, Cw, hi, vb);
            sb_block<0>(p0, o, Cw, hi, vb);
#if ATTN_EARLY_EXIT
            if (__all(Cw < 1e-37f)) { wdone = true; if (lane == 0) __hip_atomic_fetch_add((LAS unsigned*)(F.lds + MISC_OFF) + MISC_DONE, 1u, __ATOMIC_RELAXED, __HIP_MEMORY_SCOPE_WORKGROUP); }
#endif
        }
        if (more) AWRITE(cur ^ 1);
        __syncthreads();
        if (!more) break;
#if ATTN_EARLY_EXIT
        if (F.misc[MISC_DONE] == 8u) break;
#endif
    }
#undef ALOAD
#undef AWRITE
    if (myq < qend) {
        const bf16_t* gp = Pm + PC_AG * PCH + (size_t)myq * GWID + hd * 128; bf16_t* yp = Y + (size_t)myq * DMODEL + 2 * GWID + hd * 128;
#pragma unroll
        for (int db = 0; db < 4; ++db)
#pragma unroll
            for (int i = 0; i < 4; ++i) { const int d0 = 32 * db + 8 * i + 4 * hi; const u32x2 gt = *(const u32x2*)(gp + d0);
                u32x2 w; w.x = cvt_pk_bf16(o[db][4 * i] * bflo(gt.x), o[db][4 * i + 1] * bfhi(gt.x));
                w.y = cvt_pk_bf16(o[db][4 * i + 2] * bflo(gt.y), o[db][4 * i + 3] * bfhi(gt.y));
                *(u32x2*)(yp + d0) = w; }
    }
}
constexpr int ATTN_FULL = 8 * 32, ATTN_UNITS = ATTN_FULL + 8;
__device__ __forceinline__ void attn_phase(const Frame& F0, int l) {
    Frame F = F0; F.refresh();
    unsigned* head = KCTL + CW_QUEUE + 64 * l;
    for (;;) {
        if (F.tid == 0) F.misc[MISC_Q] = __hip_atomic_fetch_add(head, 1u, __ATOMIC_RELAXED, __HIP_MEMORY_SCOPE_AGENT);
        __syncthreads();
        const unsigned u = (unsigned)__builtin_amdgcn_readfirstlane((int)F.misc[MISC_Q]);
        __syncthreads();
        if (u >= (unsigned)ATTN_UNITS) break;
        { const bool full = u < (unsigned)ATTN_FULL; attn_unit(F, full ? (int)(u & 7u) : (int)(u - ATTN_FULL), full ? 16 + 256 * (31 - (int)(u >> 3)) : 0, full ? 256 : 16); }
    }
}

typedef float f32x2v __attribute__((ext_vector_type(2)));
__device__ __forceinline__ void thin_outproj(const Frame& F0, int l, bool last) {
    Frame F = F0; F.refresh();
    const int tid = F.tid, lane = F.lane, wave = F.wave, r = lane & 15, g = lane >> 4;
    unsigned char* const ws = KWS;
    for (int u = blockIdx.x; u < 256; u += F.G) {
        const bf16_t* Ap = (const bf16_t*)(ws + WS_YCAT) + (size_t)(8192 + r) * DMODEL + 512 * wave + 8 * g;
        const bf16_t* Bp = (const bf16_t*)(ws + WS_WOUT + l * SZ_WOUT_L) + (size_t)(16 * u + r) * DMODEL + 512 * wave + 8 * g;
        bf16x8 a[16], b[16];
#pragma unroll
        for (int ks = 0; ks < 16; ++ks) { a[ks] = *(const bf16x8*)(Ap + 32 * ks); b[ks] = *(const bf16x8*)(Bp + 32 * ks); }
        f32x4 acc = (f32x4){0.f, 0.f, 0.f, 0.f};
#pragma unroll
        for (int ks = 0; ks < 16; ++ks) acc = __builtin_amdgcn_mfma_f32_16x16x32_bf16(a[ks], b[ks], acc, 0, 0, 0);
        LAS float* part = (LAS float*)F.lds;
#pragma unroll
        for (int e = 0; e < 4; ++e) part[(wave * 16 + 4 * g + e) * 16 + r] = acc[e];
        __syncthreads();
        if (tid < 256) {
            const int row = tid >> 4, cc = tid & 15;
            float y = 0.f;
#pragma unroll
            for (int wv = 0; wv < 8; ++wv) y += part[(wv * 16 + row) * 16 + cc];
            const size_t off = (size_t)(8192 + row) * DMODEL + 16 * u + cc;
            bf16_t* hbp = (bf16_t*)(ws + WS_HB) + off;
            const float h = __uint_as_float((unsigned)(*hbp) << 16) + y;
            if (last) (kargs(F)->out)[off - (size_t)16 * DMODEL] = h;
            else {
                *hbp = (bf16_t)(cvt_pk_bf16(h, 0.f) & 0xffffu);
                float ss = h * h;
#pragma unroll
                for (int o = 8; o >= 1; o >>= 1) ss += __shfl_xor(ss, o);
                if (cc == 0) ((float*)(ws + WS_SSQT))[row * 256 + u] = ss;
            }
        }
        __syncthreads();
    }
}

__device__ __forceinline__ void thin_inproj(const Frame& F0, int l, int v) {
    Frame F = F0; F.refresh();
    const int tid = F.tid, lane = F.lane, wave = F.wave, r = lane & 15, g = lane >> 4;
    unsigned char* const ws = KWS;
    const int pn = v >> 1, hv = v & 1;
    const bool fused = pn < 24;
    const bf16_t* Ap = (const bf16_t*)(ws + WS_HB) + (size_t)(8192 + r) * DMODEL + 512 * wave + 8 * g;
    const bf16_t* Bp = (const bf16_t*)(ws + WS_WIN + l * SZ_WIN_L) + (size_t)(256 * pn + (fused ? 64 * hv : 128 * hv) + r) * DMODEL + 512 * wave + 8 * g;
    const int hstr = fused ? 128 - 64 : 0;
    f32x4 acc[8];
#pragma unroll
    for (int cb = 0; cb < 8; ++cb) acc[cb] = (f32x4){0.f, 0.f, 0.f, 0.f};
#pragma unroll 1
    for (int kb = 0; kb < 8; ++kb) {
        bf16x8 a[2], b[2][8];
#pragma unroll
        for (int ks = 0; ks < 2; ++ks) { a[ks] = *(const bf16x8*)(Ap + 64 * kb + 32 * ks);
#pragma unroll
            for (int cb = 0; cb < 8; ++cb) b[ks][cb] = *(const bf16x8*)(Bp + (size_t)(16 * cb + (cb >> 2) * hstr) * DMODEL + 64 * kb + 32 * ks); }
#pragma unroll
        for (int ks = 0; ks < 2; ++ks)
#pragma unroll
            for (int cb = 0; cb < 8; ++cb) acc[cb] = __builtin_amdgcn_mfma_f32_16x16x32_bf16(a[ks], b[ks][cb], acc[cb], 0, 0, 0);
    }
    LAS float* part = (LAS float*)F.lds;
#pragma unroll
    for (int cb = 0; cb < 8; ++cb)
#pragma unroll
        for (int e = 0; e < 4; ++e) part[(wave * 16 + 4 * g + e) * 128 + 16 * cb + r] = acc[cb][e];
    __syncthreads();
    {
        const int row = tid >> 5, cp = tid & 31;
        float a0 = 0.f, a1 = 0.f, b0 = 0.f, b1 = 0.f;
#pragma unroll
        for (int wv = 0; wv < 8; ++wv) { const f32x2v p2 = *(const LAS f32x2v*)(part + (wv * 16 + row) * 128 + 2 * cp), q2 = *(const LAS f32x2v*)(part + (wv * 16 + row) * 128 + 64 + 2 * cp);
            a0 += p2[0]; a1 += p2[1]; b0 += q2[0]; b1 += q2[1]; }
        const f32x4 q0 = *(const f32x4*)((const float*)(ws + WS_SSQT) + row * 256 + 8 * cp), q1 = *(const f32x4*)((const float*)(ws + WS_SSQT) + row * 256 + 8 * cp + 4);
        float ss = ((q0[0] + q0[1]) + (q0[2] + q0[3])) + ((q1[0] + q1[1]) + (q1[2] + q1[3]));
#pragma unroll
        for (int o = 16; o >= 1; o >>= 1) ss += __shfl_xor(ss, o);
        const float rstd = __builtin_amdgcn_rsqf(ss * (1.0f / 4096.0f) + 1e-6f);
        a0 *= rstd; a1 *= rstd; b0 *= rstd; b1 *= rstd;
        unsigned* pbase = (unsigned*)(ws + WS_P) + (size_t)(8192 + row) * 512;
#define PROW(cb) (pbase + (size_t)((cb) >> 10) * MPAD * 512 + ((cb) & 1023) / 2)
        if (fused) {
            float r0, r1; int cbase;
            if (pn < 8) { r0 = a0 * sigm_f(b0); r1 = a1 * sigm_f(b1); cbase = PC_GLU * 1024 + 128 * pn; }
            else if (pn < 16) { r0 = a0 * b0; r1 = a1 * b1; cbase = PC_SCSX * 1024 + 128 * (pn - 8); }
            else { r0 = a0 * silu_f(b0); r1 = a1 * silu_f(b1); cbase = PC_GB * 1024 + 128 * (pn - 16); }
            PROW(cbase + 64 * hv)[cp] = cvt_pk_bf16(r0, r1);
        } else {
            const int q = (pn - 24) >> 2, t = (pn - 24) & 3;
            const int chunk = (q == 0) ? PC_CG : (q == 1) ? PC_Q : (q == 2) ? PC_K : (q == 3) ? PC_V : (q == 4) ? PC_AG : (q == 5) ? PC_PI : PC_PG;
            if (q == 0 || q == 4 || q == 6) { a0 = silu_f(a0); a1 = silu_f(a1); b0 = silu_f(b0); b1 = silu_f(b1); }
            if (q == 1 || q == 2) {
                float hs = (a0 * a0 + a1 * a1) + (b0 * b0 + b1 * b1);
#pragma unroll
                for (int o = 16; o >= 1; o >>= 1) hs += __shfl_xor(hs, o);
                float hr = __builtin_amdgcn_rsqf(hs * (1.0f / 128.0f) + 1e-6f); if (q == 1) hr *= QSCALE;
                const float* gp = (q == 1 ? KIN(10) : KIN(11)) + l * 128;
                a0 *= hr * gp[2 * cp]; a1 *= hr * gp[2 * cp + 1]; b0 *= hr * gp[64 + 2 * cp]; b1 *= hr * gp[65 + 2 * cp];
            }
            const int cbase = chunk * 1024 + 256 * t + 128 * hv;
            PROW(cbase)[cp] = cvt_pk_bf16(a0, a1);
            PROW(cbase + 64)[cp] = cvt_pk_bf16(b0, b1);
#undef PROW
        }
    }
    __syncthreads();
}

constexpr int N_PHASES = 1 + 3 * NLAYER;
#ifndef GEMM_ALIGN
#define GEMM_ALIGN true
#endif
static_assert(GEMM_ALIGN, "the q/k-norm exchange in the in-proj epilogue takes a workgroup barrier: both half-workgroups must be in their epilogues together");
#ifndef GEMM_SP2
#define GEMM_SP2 true
#endif
__global__ void __launch_bounds__(NTHR, 2) hymba_fwd(Args args) {
    extern __shared__ __attribute__((aligned(16))) unsigned char lds_raw[];
    Frame F;
    F.lds = (LAS unsigned char*)lds_raw; F.misc = (volatile LAS unsigned*)(F.lds + MISC_OFF);
    F.tid = threadIdx.x; F.lane = F.tid & 63; F.wave = __builtin_amdgcn_readfirstlane(F.tid >> 6); F.G = gridDim.x;
    F.kp = (KArgP)__builtin_amdgcn_kernarg_segment_ptr();
    if (F.tid < 64) F.misc[F.tid] = 0u;
    __syncthreads();
    XcdBarrier bar = xcd_barrier_post(KCTL + CW_BAR, F.misc);
    const int lo = args.ph_lo, hi = args.ph_hi;
#define IN(k) (lo <= (k) && (k) < hi)
#ifndef PROBE_BAR2
#define PROBE_BAR2 0
#endif
#define SEAM(k) do { if (IN(k) && IN((k) + 1)) { xcd_barrier(bar); if (PROBE_BAR2) xcd_barrier(bar); } } while (0)
#ifndef PROBE_DUP
#define PROBE_DUP 0
#endif
    if (IN(0)) { p0_prologue(F); if (PROBE_DUP & 16) p0_prologue(F); }
    SEAM(0);
    for (int l = 0; l < NLAYER; ++l) {
        const int pb = 1 + 3 * l;
        bf16_t* Pm = (bf16_t*)(KWS + WS_P); bf16_t* Y = (bf16_t*)(KWS + WS_YCAT);
        if (IN(pb)) {
            pg8::Gemm g{(const bf16_t*)(KWS + WS_HB), (const bf16_t*)(KWS + WS_WIN + l * SZ_WIN_L), 8192, DINP, DMODEL};
            {
                const int pmrow = 256 * (4 * ((int)blockIdx.x & 7) + (((int)blockIdx.x >> 3) & 3));
                LAS float* rtab = (LAS float*)(F.lds + MISC_OFF + 12288);
                int rt_ = threadIdx.x; asm volatile("" : "+v"(rt_));
                if (rt_ < 256) { const f32x4* sp = (const f32x4*)((const float*)(KWS + WS_SSQ) + (size_t)(pmrow + rt_) * 64); f32x4 t = sp[0];
#pragma unroll
                    for (int q = 1; q < 16; ++q) t += sp[q];
                    rtab[rt_] = __builtin_amdgcn_rsqf(((t[0] + t[1]) + (t[2] + t[3])) * (1.0f / 4096.0f) + 1e-6f); }
                __syncthreads();
            }
            pg8::EpiInProj E{(bf16_t*)(KWS + WS_P), (const LAS float*)(F.lds + MISC_OFF + 12288), (LAS float*)(F.lds + MISC_OFF + 4096), KIN(10) + l * 128, KIN(11) + l * 128, QSCALE};
            int parts = 2; asm volatile("" : "+s"(parts));
#pragma unroll 1
            for (int part = 0; part < parts; ++part) {
                pg8::XcdOrder S{part ? DINP / 256 : 32, (int)blockIdx.x, 1, part ? 4 : 0};
                pg8::gemm_phase<pg8::EpiInProj, pg8::XcdOrder, GEMM_ALIGN, GEMM_SP2>(F.lds, g, S, E);
                if (part == 0) publish_add(KCTL + CW_RDY + 64 * l);
            }
            { const int rem = (32 * 52) % F.G, v = (int)blockIdx.x - rem;
              for (int vv = v; v >= 0 && vv < 104; vv += F.G - rem) thin_inproj(F, l, vv);
              if (v >= 0 && v < 104) publish_add(KCTL + CW_THIN + 64 * l); }
            __syncthreads();
            prep_queue(F, l);
            if (l + 1 < NLAYER) convert_units<false>(F, l + 1, (int)blockIdx.x, F.G, (CU_L - (int)blockIdx.x + F.G - 1) / F.G);
        }
        SEAM(pb);
        if (IN(pb + 1)) {
            { pg8::Gemm g{(const bf16_t*)(KWS + WS_ALN), (const bf16_t*)(KWS + WS_WPW + l * SZ_WPW_L), MPAD, GWID, GWID};
              pg8::StaticOrder S; S.init(MPAD, GWID, F.G, (int)blockIdx.x);
              pg8::EpiPw E{Pm, Y};
              pg8::gemm_phase<pg8::EpiPw, pg8::StaticOrder, true, true>(F.lds, g, S, E);
              if (PROBE_DUP & 4) pg8::gemm_phase<pg8::EpiPw, pg8::StaticOrder, true, true>(F.lds, g, S, E); }
            { int kpool = 256; asm volatile("" : "+s"(kpool));
              pg8::Gemm g{(const bf16_t*)(KWS + WS_POOLED), (const bf16_t*)(KWS + WS_WPOOL + l * SZ_WPOOL_L), 4 * MPAD, 1024, kpool};
              pg8::PoolOrder S{124, (int)blockIdx.x >= 132 ? (int)blockIdx.x - 132 : 4096};
              pg8::EpiPool E{Pm, Y, KIN(13) + l * GWID};
              pg8::gemm_phase<pg8::EpiPool, pg8::PoolOrder, true, true>(F.lds, g, S, E);
              if (PROBE_DUP & 4) pg8::gemm_phase<pg8::EpiPool, pg8::PoolOrder, true, true>(F.lds, g, S, E); }
            __syncthreads();
            attn_phase(F, l);
            if (PROBE_DUP & 8) attn_phase(F, l + 4);
        }
        SEAM(pb + 1);
        if (IN(pb + 2)) {
            const bool last = (l == NLAYER - 1);
            thin_outproj(F, l, last);
            pg8::Gemm g{(const bf16_t*)Y, (const bf16_t*)(KWS + WS_WOUT + l * SZ_WOUT_L), 8192, DMODEL, DMODEL};
            pg8::XcdOrder S{DMODEL / 256, (int)blockIdx.x, 0, 0};
            pg8::EpiOutProj E{(bf16_t*)(KWS + WS_HB), (kargs(F)->out), 16, (float*)(KWS + WS_SSQ), last ? 1 : 0};
            int reps = ((PROBE_DUP & 32) && last) ? 2 : 1; asm volatile("" : "+s"(reps));
#pragma unroll 1
            for (int rep = 0; rep < reps; ++rep) pg8::gemm_phase<pg8::EpiOutProj, pg8::XcdOrder, GEMM_ALIGN, GEMM_SP2>(F.lds, g, S, E);
        }
        SEAM(pb + 2);
    }
#undef IN
#undef SEAM
}

extern "C" void kernel_launch(void* const* d_in, const int* in_sizes, int n_in, void* d_out, int out_size, void* d_ws, size_t ws_size, hipStream_t stream) {
    static int grid = 0;
    if (grid == 0) {
        if (n_in != 15 || ws_size < WS_END) { fprintf(stderr, "kernel_launch: expected 15 inputs and >= %zu bytes of workspace (got %d, %zu)\n", (size_t)WS_END, n_in, ws_size); grid = -1; return; }
        int dev = 0, cus = 0, per_cu = 0;
        if (hipGetDevice(&dev) != hipSuccess || hipDeviceGetAttribute(&cus, hipDeviceAttributeMultiprocessorCount, dev) != hipSuccess) { grid = -1; return; }
        if (hipFuncSetAttribute((const void*)hymba_fwd, hipFuncAttributeMaxDynamicSharedMemorySize, LDS_BYTES) != hipSuccess) { fprintf(stderr, "kernel_launch: hipFuncSetAttribute failed\n"); grid = -1; return; }
        if (hipOccupancyMaxActiveBlocksPerMultiprocessor(&per_cu, (const void*)hymba_fwd, NTHR, LDS_BYTES) != hipSuccess || per_cu < 1) { fprintf(stderr, "kernel_launch: occupancy query says %d blocks per CU\n", per_cu); per_cu = 1; }
        (void)hipGetLastError();
        grid = cus;
        if (cus != 256) fprintf(stderr, "kernel_launch: built for 256 CUs (8 XCDs x 32); found %d: the GEMM unit order assumes a grid of 256\n", cus);
    }
    if (grid < 0) return;
    (void)hipMemsetAsync((char*)d_ws + WS_CTL, 0, CTL_BYTES, stream);
    Args a{};
    for (int i = 0; i < 15; ++i) a.in[i] = (const float*)d_in[i];
    a.out = (float*)d_out; a.ws = (unsigned char*)d_ws;
#if MK_N_LAUNCHES == 1
    a.ph_lo = 0; a.ph_hi = N_PHASES;
    hipLaunchKernelGGL(hymba_fwd, dim3(grid), dim3(NTHR), LDS_BYTES, stream, a);
#else
    for (int p = 0; p < N_PHASES; ++p) { a.ph_lo = p; a.ph_hi = p + 1; hipLaunchKernelGGL(hymba_fwd, dim3(grid), dim3(NTHR), LDS_BYTES, stream, a); }
#endif
    (void)in_sizes; (void)out_size;
}
```

```cpp
#include <hip/hip_runtime.h>
#include <cstdio>
#include <cstdint>

#ifndef MK_N_LAUNCHES
#define MK_N_LAUNCHES 1
#endif

namespace pg8 {
#define PG8_LAS __attribute__((address_space(3)))
typedef unsigned short bf16_t;
typedef short bf16x8 __attribute__((ext_vector_type(8)));
typedef float f32x4 __attribute__((ext_vector_type(4)));
typedef unsigned u32x4 __attribute__((ext_vector_type(4)));
constexpr int BM = 256, BK = 64, HALF = 128, HTB = HALF * BK * 2  , STAGE_BYTES = 8 * HTB, NXCD = 8, WGM = 8;

__host__ __device__ __forceinline__ int lds_byte(int r, int c) { const int st = (r >> 4) * 2 + (c >> 5), rr = r & 15, cc = c & 31, ob = rr * 64 + cc * 2; return st * 1024 + (ob ^ (((ob >> 9) & 1) << 5)); }
__host__ __device__ __forceinline__ void stage_rc(int b, int& R, int& C) { const int st = b / 1024, sb = b % 1024, swz = sb ^ (((sb >> 9) & 1) << 5); R = (st >> 1) * 16 + swz / 64; C = (st & 1) * 32 + (swz % 64) / 2; }
__host__ __device__ __forceinline__ int perm32(int rho) { const int n = rho >> 4, i = rho & 15; return 8 * (i >> 2) + 4 * n + (i & 3); }

struct Unit { int pm, pn; };
struct Gemm { const bf16_t* A; const bf16_t* Bt; int M, N, K; };

struct StaticOrder {
    int nM, nN, nwg, G, c;
    __host__ __device__ void init(int M, int N, int G_, int c_) { nM = M / BM; nN = N / BM; nwg = nM * nN; G = G_; c = c_; }
    __host__ __device__ bool next(int i, Unit& u) const {
        const long L = (long)i * G + c; if (L >= nwg) return false;
        int wgid = (int)L; { const int q = nwg / NXCD, r = nwg % NXCD, xcd = wgid % NXCD, off = wgid / NXCD; wgid = (xcd < r ? xcd * (q + 1) : r * (q + 1) + (xcd - r) * q) + off; }
        const int nig = WGM * nN, gid = wgid / nig, fm = gid * WGM, gsz = (nM - fm) < WGM ? (nM - fm) : WGM;
        u.pm = fm + ((wgid % nig) % gsz); u.pn = (wgid % nig) / gsz; return true;
    }
    __device__ __forceinline__ void a_ready(const Unit&) const {}
    __device__ __forceinline__ void done(const Unit&) const {}
};
__device__ __forceinline__ unsigned cvt_pk_bf16(float lo, float hi) { unsigned r; asm("v_cvt_pk_bf16_f32 %0, %1, %2" : "=v"(r) : "v"(lo), "v"(hi)); return r; }
template <class Epi, class Sched, bool ALIGN_EPI = false, bool SP2 = false>
__device__ __forceinline__ void gemm_phase(PG8_LAS unsigned char* lds, const Gemm g, const Sched& S, const Epi& E) {
    int tid_ = threadIdx.x; asm volatile("" : "+v"(tid_));
    const int tid = tid_, wid = __builtin_amdgcn_readfirstlane(tid >> 6), lane = tid & 63, wr = wid >> 2, wc = wid & 3, fr = lane & 15, fq = lane >> 4;
    const int K = g.K, nt = K / BK;
    unsigned voffA[2], voffB[2];
#pragma unroll
    for (int i = 0; i < 2; ++i) { int R, C; stage_rc(tid * 16 + i * 8192, R, C); const int Rb = Epi::PERM ? ((R & ~31) + perm32(R & 31)) : R;
        voffA[i] = (unsigned)(R * K + C) * 2u; voffB[i] = (unsigned)(Rb * K + C) * 2u; }
    const size_t kstep = (size_t)(BK * 2);
    const size_t hstep = (size_t)HALF * K * 2;
    const size_t tstep = 2 * hstep;
    const unsigned ldsw = (unsigned)wid * 1024u;
    const int aoff = lds_byte(wr * 64 + fr, fq * 8), boff = lds_byte(wc * 32 + fr, fq * 8);
#define PG8_SA(b, h) (((b) * 2 + (h)) * HTB)
#define PG8_SB(b, h) ((4 + (b) * 2 + (h)) * HTB)
#define PG8_STAGE(bufoff, gbase, voff) do { _Pragma("unroll") for (int _i = 0; _i < 2; ++_i) \
        __builtin_amdgcn_global_load_lds((const unsigned*)((const char*)(gbase) + (voff)[_i]), (PG8_LAS unsigned*)(lds + (bufoff) + ldsw + _i * 8192), 16, 0, 0); } while (0)
#define PG8_LDA(dst, b, h) do { _Pragma("unroll") for (int m = 0; m < 4; ++m) _Pragma("unroll") for (int k = 0; k < 2; ++k) dst[m][k] = *(const PG8_LAS bf16x8*)(lds + PG8_SA(b, h) + aoff + m * 2048 + k * 1024); } while (0)
#define PG8_LDB(dst, b, h) do { _Pragma("unroll") for (int n = 0; n < 2; ++n) _Pragma("unroll") for (int k = 0; k < 2; ++k) dst[n][k] = *(const PG8_LAS bf16x8*)(lds + PG8_SB(b, h) + boff + n * 2048 + k * 1024); } while (0)
#define PG8_MMA(ai, bj, At, Bt) do { __builtin_amdgcn_s_setprio(1); _Pragma("unroll") for (int m = 0; m < 4; ++m) _Pragma("unroll") for (int n = 0; n < 2; ++n) _Pragma("unroll") for (int k = 0; k < 2; ++k) \
        acc[ai][bj][m][n] = __builtin_amdgcn_mfma_f32_16x16x32_bf16(Bt[n][k], At[m][k], acc[ai][bj][m][n], 0, 0, 0); __builtin_amdgcn_s_setprio(0); } while (0)
#define PG8_WAIT_V(n) asm volatile("s_waitcnt vmcnt(" #n ")" ::: "memory")
#define PG8_WAIT_L(n) asm volatile("s_waitcnt lgkmcnt(" #n ")" ::: "memory")
#define PG8_BAR __builtin_amdgcn_s_barrier()
#define PG8_SCHED __builtin_amdgcn_sched_barrier(0)
    Unit cur, nxt; int ui = 0;
    if (!S.next(0, cur)) return;
    f32x4 acc[2][2][4][2];
#pragma unroll
    for (int a = 0; a < 2; ++a)
#pragma unroll
        for (int b = 0; b < 2; ++b)
#pragma unroll
            for (int m = 0; m < 4; ++m)
#pragma unroll
                for (int n = 0; n < 2; ++n) acc[a][b][m][n] = (f32x4){0.f, 0.f, 0.f, 0.f};
    bf16x8 At[4][2], B0[2][2], B1[2][2];
    const char* cA = (const char*)g.A + (size_t)cur.pm * tstep; const char* cB = (const char*)g.Bt + (size_t)cur.pn * tstep;
    S.a_ready(cur);
    if constexpr (SP2) {
        PG8_STAGE(PG8_SB(0, 0), cB, voffB); PG8_STAGE(PG8_SB(0, 1), cB + hstep, voffB); PG8_STAGE(PG8_SA(0, 0), cA, voffA); PG8_STAGE(PG8_SA(0, 1), cA + hstep, voffA);
        if (wr == 1) PG8_BAR;
        PG8_WAIT_V(2); PG8_BAR;
        PG8_STAGE(PG8_SB(1, 0), cB + kstep, voffB); PG8_STAGE(PG8_SA(1, 0), cA + kstep, voffA); PG8_STAGE(PG8_SB(1, 1), cB + hstep + kstep, voffB);
        PG8_WAIT_V(6); PG8_BAR;
    } else {
        PG8_STAGE(PG8_SB(0, 0), cB, voffB); PG8_STAGE(PG8_SA(0, 0), cA, voffA); PG8_STAGE(PG8_SB(0, 1), cB + hstep, voffB); PG8_STAGE(PG8_SA(0, 1), cA + hstep, voffA);
        if (wr == 1) PG8_BAR;
        PG8_WAIT_V(4); PG8_BAR;
        PG8_STAGE(PG8_SB(1, 0), cB + kstep, voffB); PG8_STAGE(PG8_SA(1, 0), cA + kstep, voffA); PG8_STAGE(PG8_SB(1, 1), cB + hstep + kstep, voffB);
        PG8_WAIT_V(6); PG8_BAR;
    }
    for (;;) {
        const bool has_next = S.next(ui + 1, nxt);
        const char* nA = has_next ? (const char*)g.A + (size_t)nxt.pm * tstep : cA; const char* nB = has_next ? (const char*)g.Bt + (size_t)nxt.pn * tstep : cB;
        for (int t = 0; t < nt; t += 2) {
            const bool last = (t == nt - 2);
            const char* a1 = cA + (size_t)(t + 1) * kstep;
            const char* a2 = last ? nA : cA + (size_t)(t + 2) * kstep; const char* b2 = last ? nB : cB + (size_t)(t + 2) * kstep;
            const char* a3 = a2 + kstep; const char* b3 = b2 + kstep;
            if (last && has_next) S.a_ready(nxt);
            if constexpr (SP2) {
            PG8_LDB(B0, 0, 0); PG8_LDB(B1, 0, 1); PG8_SCHED; PG8_LDA(At, 0, 0); PG8_STAGE(PG8_SA(1, 1), a1 + hstep, voffA);
            PG8_WAIT_V(8); PG8_WAIT_L(0); PG8_BAR; PG8_MMA(0, 0, At, B0); PG8_MMA(0, 1, At, B1); PG8_BAR; PG8_SCHED;
            PG8_LDA(At, 0, 1); PG8_STAGE(PG8_SB(0, 0), b2, voffB); PG8_STAGE(PG8_SB(0, 1), b2 + hstep, voffB); PG8_STAGE(PG8_SA(0, 0), a2, voffA);
            PG8_WAIT_V(8); PG8_WAIT_L(0); PG8_BAR; PG8_MMA(1, 0, At, B0); PG8_MMA(1, 1, At, B1); PG8_BAR; PG8_SCHED;
            PG8_LDB(B0, 1, 0); PG8_LDB(B1, 1, 1); PG8_SCHED; PG8_LDA(At, 1, 0); PG8_STAGE(PG8_SA(0, 1), a2 + hstep, voffA);
            PG8_WAIT_V(8); PG8_WAIT_L(0); PG8_BAR; PG8_MMA(0, 0, At, B0); PG8_MMA(0, 1, At, B1); PG8_BAR; PG8_SCHED;
            PG8_LDA(At, 1, 1); PG8_STAGE(PG8_SB(1, 0), b3, voffB); PG8_STAGE(PG8_SB(1, 1), b3 + hstep, voffB); PG8_STAGE(PG8_SA(1, 0), a3, voffA);
            PG8_WAIT_V(8); PG8_WAIT_L(0); PG8_BAR; PG8_MMA(1, 0, At, B0); PG8_MMA(1, 1, At, B1); PG8_BAR; PG8_SCHED;
            } else {
            PG8_LDB(B0, 0, 0); PG8_SCHED; PG8_LDA(At, 0, 0); PG8_STAGE(PG8_SA(1, 1), a1 + hstep, voffA);
            PG8_WAIT_L(8); PG8_BAR; PG8_WAIT_L(0); PG8_MMA(0, 0, At, B0); PG8_BAR; PG8_SCHED;
            PG8_LDB(B1, 0, 1); PG8_STAGE(PG8_SB(0, 0), b2, voffB);
            PG8_BAR; PG8_WAIT_L(0); PG8_MMA(0, 1, At, B1); PG8_BAR;
            PG8_LDA(At, 0, 1); PG8_STAGE(PG8_SA(0, 0), a2, voffA);
            PG8_BAR; PG8_WAIT_L(0); PG8_MMA(1, 0, At, B0); PG8_BAR; PG8_SCHED;
            PG8_STAGE(PG8_SB(0, 1), b2 + hstep, voffB);
            PG8_WAIT_V(6); PG8_BAR; PG8_MMA(1, 1, At, B1); PG8_BAR;
            PG8_LDB(B0, 1, 0); PG8_SCHED; PG8_LDA(At, 1, 0); PG8_STAGE(PG8_SA(0, 1), a2 + hstep, voffA);
            PG8_WAIT_L(8); PG8_BAR; PG8_WAIT_L(0); PG8_MMA(0, 0, At, B0); PG8_BAR; PG8_SCHED;
            PG8_LDB(B1, 1, 1); PG8_STAGE(PG8_SB(1, 0), b3, voffB);
            PG8_BAR; PG8_WAIT_L(0); PG8_MMA(0, 1, At, B1); PG8_BAR;
            PG8_LDA(At, 1, 1); PG8_STAGE(PG8_SA(1, 0), a3, voffA);
            PG8_BAR; PG8_WAIT_L(0); PG8_MMA(1, 0, At, B0); PG8_BAR; PG8_SCHED;
            PG8_STAGE(PG8_SB(1, 1), b3 + hstep, voffB);
            PG8_WAIT_V(6); PG8_BAR; PG8_MMA(1, 1, At, B1); PG8_BAR;
            }
        }
        if constexpr (ALIGN_EPI) { if (wr == 0) PG8_BAR; }
        if constexpr (!Epi::AFTER_DRAIN) { E(acc, cur, wr, wc, fr, fq); S.done(cur); }
        if (!has_next) break;
#pragma unroll
        for (int a = 0; a < 2; ++a)
#pragma unroll
            for (int b = 0; b < 2; ++b)
#pragma unroll
                for (int m = 0; m < 4; ++m)
#pragma unroll
                    for (int n = 0; n < 2; ++n) acc[a][b][m][n] = (f32x4){0.f, 0.f, 0.f, 0.f};
        cur = nxt; cA = nA; cB = nB; ++ui;
        if constexpr (ALIGN_EPI) { if (wr == 1) PG8_BAR; }
    }
    PG8_WAIT_V(0);
    if constexpr (!ALIGN_EPI) { if (wr == 0) PG8_BAR; }
    PG8_BAR;
    if constexpr (Epi::AFTER_DRAIN) { E.fused(acc, cur, wr, wc, fr, fq, lds, wid, lane); S.done(cur); }
#undef PG8_SA
#undef PG8_SB
#undef PG8_STAGE
#undef PG8_LDA
#undef PG8_LDB
#undef PG8_MMA
#undef PG8_WAIT_V
#undef PG8_WAIT_L
#undef PG8_BAR
#undef PG8_SCHED
}


typedef unsigned u32x2 __attribute__((ext_vector_type(2)));
constexpr int L_TOK = 8208;
constexpr int MPAD  = 8448;
constexpr int DMODEL = 4096, DINP = 13312, GWID = 1024;
constexpr int PW = 10 * 1024;
constexpr size_t PCH = (size_t)MPAD * 1024;
constexpr int PC_GLU = 0, PC_CG = 1, PC_SCSX = 2, PC_GB = 3, PC_Q = 4, PC_K = 5, PC_V = 6, PC_AG = 7, PC_PI = 8, PC_PG = 9;
__host__ __device__ __forceinline__ int win_dst_blk(int srcblk) {
    const int ch = srcblk >> 3, t = srcblk & 7;
    switch (ch) { case 0: return 2 * t; case 1: return 2 * t + 1; case 4: return 16 + 2 * t; case 5: return 17 + 2 * t; case 3: return 32 + 2 * t; case 6: return 33 + 2 * t;
                  case 2: return 48 + t; case 7: return 56 + t; case 8: return 64 + t; case 9: return 72 + t; case 10: return 80 + t; case 11: return 88 + t; default: return 96 + t; }
}

__device__ __forceinline__ float silu_f(float x) { return x * __builtin_amdgcn_rcpf(1.0f + __builtin_amdgcn_exp2f(x * -1.4426950408889634f)); }
__device__ __forceinline__ float sigm_f(float x) { return __builtin_amdgcn_rcpf(1.0f + __builtin_amdgcn_exp2f(x * -1.4426950408889634f)); }
__device__ __forceinline__ float bflo(unsigned u) { return __uint_as_float(u << 16); }
__device__ __forceinline__ float bfhi(unsigned u) { return __uint_as_float(u & 0xffff0000u); }

struct EpiInProj {
    static constexpr bool PERM = true, AFTER_DRAIN = false;
    bf16_t* P; const PG8_LAS float* rtab;
    PG8_LAS float* red;
    const float* qg; const float* kg;
    float qscale;
    __device__ __forceinline__ void operator()(const f32x4 (&acc)[2][2][4][2], const Unit& u, int wr, int wc, int fr, int fq) const {
        const int row0 = u.pm * BM + wr * 64 + fr, pn = u.pn, cin = wc * 32 + 8 * fq;
        const bool qk = (pn >= 28 && pn < 36);
        if (qk) {
#pragma unroll
            for (int ai = 0; ai < 2; ++ai)
#pragma unroll
                for (int m = 0; m < 4; ++m)
#pragma unroll
                    for (int bj = 0; bj < 2; ++bj) { const f32x4 x0 = acc[ai][bj][m][0], x1 = acc[ai][bj][m][1];
                        float s = ((x0[0] * x0[0] + x0[1] * x0[1]) + (x0[2] * x0[2] + x0[3] * x0[3])) + ((x1[0] * x1[0] + x1[1] * x1[1]) + (x1[2] * x1[2] + x1[3] * x1[3]));
                        s += __shfl_xor(s, 16); s += __shfl_xor(s, 32);
                        if (fq == 0) red[(bj * 256 + ai * HALF + wr * 64 + m * 16 + fr) * 4 + wc] = s; }
            asm volatile("s_waitcnt lgkmcnt(0)" ::: "memory"); __builtin_amdgcn_s_barrier(); asm volatile("" ::: "memory");
        }
        int kind, cbase;
        if (pn < 8) { kind = 0; cbase = PC_GLU * 1024 + 128 * pn; } else if (pn < 16) { kind = 1; cbase = PC_SCSX * 1024 + 128 * (pn - 8); } else if (pn < 24) { kind = 2; cbase = PC_GB * 1024 + 128 * (pn - 16); }
        else { const int q = (pn - 24) >> 2, t = (pn - 24) & 3;
            kind = (q == 0 || q == 4 || q == 6) ? 4 : 3;
            const int chunk = (q == 0) ? PC_CG : (q == 1) ? PC_Q : (q == 2) ? PC_K : (q == 3) ? PC_V : (q == 4) ? PC_AG : (q == 5) ? PC_PI : PC_PG;
            cbase = chunk * 1024 + 256 * t; }
#pragma unroll
        for (int ai = 0; ai < 2; ++ai)
#pragma unroll
        for (int mh = 0; mh < 2; ++mh) {
#pragma unroll
            for (int mm = 0; mm < 2; ++mm) {
                const int m = 2 * mh + mm, row = row0 + ai * HALF + m * 16;
                const float rstd = rtab[ai * HALF + wr * 64 + m * 16 + fr];
                bf16_t* rowp = P + (size_t)(cbase >> 10) * PCH + (size_t)row * 1024 + (cbase & 1023) + cin;
                const f32x4 a0 = acc[ai][0][m][0] * rstd, a1 = acc[ai][0][m][1] * rstd, b0 = acc[ai][1][m][0] * rstd, b1 = acc[ai][1][m][1] * rstd;
                if (kind <= 2) {
                    f32x4 r0, r1;
                    if (kind == 0) { for (int e = 0; e < 4; ++e) { r0[e] = a0[e] * sigm_f(b0[e]); r1[e] = a1[e] * sigm_f(b1[e]); } }
                    else if (kind == 1) { r0 = a0 * b0; r1 = a1 * b1; }
                    else { for (int e = 0; e < 4; ++e) { r0[e] = a0[e] * silu_f(b0[e]); r1[e] = a1[e] * silu_f(b1[e]); } }
                    u32x4 w; w.x = cvt_pk_bf16(r0[0], r0[1]); w.y = cvt_pk_bf16(r0[2], r0[3]); w.z = cvt_pk_bf16(r1[0], r1[1]); w.w = cvt_pk_bf16(r1[2], r1[3]);
                    *(u32x4*)rowp = w;
                } else {
                    f32x4 x0 = a0, x1 = a1, y0 = b0, y1 = b1;
                    if (qk) {
                        const int rl = ai * HALF + wr * 64 + m * 16 + fr;
                        const f32x4 sa = *(const PG8_LAS f32x4*)(red + rl * 4), sb = *(const PG8_LAS f32x4*)(red + (256 + rl) * 4);
                        const float r2 = rstd * rstd * (1.0f / 128.0f);
                        float ha = __builtin_amdgcn_rsqf(((sa[0] + sa[1]) + (sa[2] + sa[3])) * r2 + 1e-6f), hb2 = __builtin_amdgcn_rsqf(((sb[0] + sb[1]) + (sb[2] + sb[3])) * r2 + 1e-6f);
                        const float* gp = (pn < 32) ? qg : kg; if (pn < 32) { ha *= qscale; hb2 *= qscale; }
                        const f32x4 g0 = *(const f32x4*)(gp + cin), g1 = *(const f32x4*)(gp + cin + 4);
                        x0 = x0 * g0 * ha; x1 = x1 * g1 * ha; y0 = y0 * g0 * hb2; y1 = y1 * g1 * hb2;
                    }
                    if (kind == 4) { for (int e = 0; e < 4; ++e) { x0[e] = silu_f(x0[e]); x1[e] = silu_f(x1[e]); y0[e] = silu_f(y0[e]); y1[e] = silu_f(y1[e]); } }
                    u32x4 w; w.x = cvt_pk_bf16(x0[0], x0[1]); w.y = cvt_pk_bf16(x0[2], x0[3]); w.z = cvt_pk_bf16(x1[0], x1[1]); w.w = cvt_pk_bf16(x1[2], x1[3]);
                    *(u32x4*)rowp = w;
                    u32x4 v; v.x = cvt_pk_bf16(y0[0], y0[1]); v.y = cvt_pk_bf16(y0[2], y0[3]); v.z = cvt_pk_bf16(y1[0], y1[1]); v.w = cvt_pk_bf16(y1[2], y1[3]);
                    *(u32x4*)(rowp + HALF) = v;
                }
            }
            asm volatile("" ::: "memory");
        }
    }
};

struct EpiOutProj {
    static constexpr bool PERM = true, AFTER_DRAIN = false;
    bf16_t* hb; float* hout; int out_row_off; float* ssq; int last;
    __device__ __forceinline__ void operator()(const f32x4 (&acc)[2][2][4][2], const Unit& u, int wr, int wc, int fr, int fq) const {
        const int row0 = u.pm * BM + wr * 64 + fr, col0 = u.pn * BM + wc * 32 + 8 * fq;
        u32x4 bva[2][4][2];
#pragma unroll
        for (int ai = 0; ai < 2; ++ai)
#pragma unroll
                for (int mm = 0; mm < 4; ++mm) { const int row = row0 + ai * HALF + mm * 16; const int rr = row < L_TOK ? row : 0;
                    const bf16_t* bp = hb + (size_t)rr * DMODEL + col0;
#pragma unroll
                    for (int bj = 0; bj < 2; ++bj) bva[ai][mm][bj] = *(const u32x4*)(bp + bj * HALF); }
#pragma unroll
        for (int ai = 0; ai < 2; ++ai) {
#pragma unroll
                for (int mm = 0; mm < 4; ++mm) {
                    const int m = mm, row = row0 + ai * HALF + m * 16;
                    if (row < L_TOK) {
                        f32x4 o[2][2]; float ss = 0.f;
#pragma unroll
                        for (int bj = 0; bj < 2; ++bj) { const u32x4 b = bva[ai][mm][bj]; const f32x4 a0 = acc[ai][bj][m][0], a1 = acc[ai][bj][m][1];
                            f32x4 q0, q1; q0[0] = bflo(b.x) + a0[0]; q0[1] = bfhi(b.x) + a0[1]; q0[2] = bflo(b.y) + a0[2]; q0[3] = bfhi(b.y) + a0[3];
                            q1[0] = bflo(b.z) + a1[0]; q1[1] = bfhi(b.z) + a1[1]; q1[2] = bflo(b.w) + a1[2]; q1[3] = bfhi(b.w) + a1[3]; o[bj][0] = q0; o[bj][1] = q1;
                            ss += ((q0[0] * q0[0] + q0[1] * q0[1]) + (q0[2] * q0[2] + q0[3] * q0[3])) + ((q1[0] * q1[0] + q1[1] * q1[1]) + (q1[2] * q1[2] + q1[3] * q1[3])); }
                        if (last) {
                            if (row >= out_row_off) { float* op = hout + (size_t)(row - out_row_off) * DMODEL + col0;
#pragma unroll
                                for (int bj = 0; bj < 2; ++bj) { *(f32x4*)(op + bj * HALF) = o[bj][0]; *(f32x4*)(op + bj * HALF + 4) = o[bj][1]; } }
                        } else {
                            bf16_t* hp = hb + (size_t)row * DMODEL + col0;
#pragma unroll
                            for (int bj = 0; bj < 2; ++bj) { u32x4 w; w.x = cvt_pk_bf16(o[bj][0][0], o[bj][0][1]); w.y = cvt_pk_bf16(o[bj][0][2], o[bj][0][3]); w.z = cvt_pk_bf16(o[bj][1][0], o[bj][1][1]); w.w = cvt_pk_bf16(o[bj][1][2], o[bj][1][3]);
                                *(u32x4*)(hp + bj * HALF) = w; }
                            ss += __shfl_xor(ss, 16); ss += __shfl_xor(ss, 32);
                            if (fq == 0) ssq[(size_t)row * 64 + u.pn * 4 + wc] = ss;
                        }
                    }
                }
                asm volatile("" ::: "memory");
            }
    }
};

struct EpiPw {
    static constexpr bool PERM = true, AFTER_DRAIN = false;
    const bf16_t* P; bf16_t* Y;
    __device__ __forceinline__ void operator()(const f32x4 (&acc)[2][2][4][2], const Unit& u, int wr, int wc, int fr, int fq) const {
        const int row0 = u.pm * BM + wr * 64 + fr, col0 = u.pn * BM + wc * 32 + 8 * fq;
        u32x4 gta[2][4][2];
#pragma unroll
        for (int ai = 0; ai < 2; ++ai)
#pragma unroll
            for (int m = 0; m < 4; ++m)
#pragma unroll
                for (int bj = 0; bj < 2; ++bj) gta[ai][m][bj] = *(const u32x4*)(P + PC_CG * PCH + (size_t)(row0 + ai * HALF + m * 16) * 1024 + col0 + bj * HALF);
#pragma unroll
        for (int ai = 0; ai < 2; ++ai) {
#pragma unroll
            for (int m = 0; m < 4; ++m) {
                const int row = row0 + ai * HALF + m * 16;
#pragma unroll
                for (int bj = 0; bj < 2; ++bj) {
                    const u32x4 g4 = gta[ai][m][bj]; const f32x4 a0 = acc[ai][bj][m][0], a1 = acc[ai][bj][m][1];
                    u32x4 w;
                    w.x = cvt_pk_bf16(a0[0] * bflo(g4.x), a0[1] * bfhi(g4.x));
                    w.y = cvt_pk_bf16(a0[2] * bflo(g4.y), a0[3] * bfhi(g4.y));
                    w.z = cvt_pk_bf16(a1[0] * bflo(g4.z), a1[1] * bfhi(g4.z));
                    w.w = cvt_pk_bf16(a1[2] * bflo(g4.w), a1[3] * bfhi(g4.w));
                    *(u32x4*)(Y + (size_t)row * DMODEL + col0 + bj * HALF) = w;
                }
            }
            asm volatile("" ::: "memory");
        }
    }
};

struct EpiPool {
    static constexpr bool PERM = true, AFTER_DRAIN = false;
    const bf16_t* P; bf16_t* Y; const float* pscale;
    __device__ __forceinline__ void operator()(const f32x4 (&acc)[2][2][4][2], const Unit& u, int wr, int wc, int fr, int fq) const {
        const int g = u.pn, pmr = u.pm - 33 * g;
        const int row0 = pmr * BM + wr * 64 + fr, ch0 = 256 * g + wc * 32 + 8 * fq;
#pragma unroll
        for (int ai = 0; ai < 2; ++ai) {
            u32x4 gt[4][2];
#pragma unroll
            for (int m = 0; m < 4; ++m)
#pragma unroll
                for (int bj = 0; bj < 2; ++bj) gt[m][bj] = *(const u32x4*)(P + PC_PG * PCH + (size_t)(row0 + ai * HALF + m * 16) * 1024 + (ch0 & 1023) + bj * HALF);
#pragma unroll
            for (int bj = 0; bj < 2; ++bj) {
                const int ch = ch0 + bj * HALF;
                const f32x4 sc0 = *(const f32x4*)(pscale + ch), sc1 = *(const f32x4*)(pscale + ch + 4);
#pragma unroll
                for (int m = 0; m < 4; ++m) {
                    const int row = row0 + ai * HALF + m * 16;
                    const u32x4 g4 = gt[m][bj]; const f32x4 a0 = acc[ai][bj][m][0] * sc0, a1 = acc[ai][bj][m][1] * sc1;
                    u32x4 w;
                    w.x = cvt_pk_bf16(a0[0] * bflo(g4.x), a0[1] * bfhi(g4.x));
                    w.y = cvt_pk_bf16(a0[2] * bflo(g4.y), a0[3] * bfhi(g4.y));
                    w.z = cvt_pk_bf16(a1[0] * bflo(g4.z), a1[1] * bfhi(g4.z));
                    w.w = cvt_pk_bf16(a1[2] * bflo(g4.w), a1[3] * bfhi(g4.w));
                    *(u32x4*)(Y + (size_t)row * DMODEL + 3 * GWID + ch) = w;
                }
            }
            asm volatile("" ::: "memory");
        }
    }
};
struct PoolOrder {
    int G, c;
    __device__ __forceinline__ bool next(int i, Unit& u) const { const int Lx = i * G + c; if (Lx >= 132) return false; u.pm = Lx; u.pn = Lx / 33; return true; }
    __device__ __forceinline__ void a_ready(const Unit&) const {}
    __device__ __forceinline__ void done(const Unit&) const {}
};
struct XcdOrder {
    int nN, c, inproj, i0;
    __device__ __forceinline__ bool next(int i, Unit& u) const { const int rank = c >> 3, s = 8 * (i + i0) + (rank >> 2); if (s >= nN) return false;
        const int pn = !inproj ? s : (s < 24) ? s : (s < 28) ? s + 20 : (s < 48) ? s - 4 : s; int pm = 4 * (c & 7) + (rank & 3); asm volatile("" : "+s"(pm));
        u.pm = pm; u.pn = pn; return true; }
    __device__ __forceinline__ void a_ready(const Unit&) const {}
    __device__ __forceinline__ void done(const Unit&) const {}
};
}


#define XB_TMO      128
#define XB_XCNT(j)  (256  + 64 * (j))
#define XB_XSUB(j)  (1280 + 64 * (j))
#define XB_XGEN(j)  (2304 + 64 * (j))
#define XB_TOP      3328
#define XB_TOPGEN   3392
#define XCD_BAR_WORDS 3456
#define XB_SPIN_CAP (1u << 18)
#define LAS __attribute__((address_space(3)))

__device__ __forceinline__ unsigned xb_ld(unsigned* p)              { return __hip_atomic_load(p, __ATOMIC_RELAXED, __HIP_MEMORY_SCOPE_AGENT); }
__device__ __forceinline__ unsigned xb_add(unsigned* p, unsigned v) { return __hip_atomic_fetch_add(p, v, __ATOMIC_RELAXED, __HIP_MEMORY_SCOPE_AGENT); }
__device__ __forceinline__ unsigned xb_xcc_id() { return (unsigned)__builtin_amdgcn_s_getreg((3 << 11) | 20) & 0xFu; }
#define XB_SPIN(cond, bar) do { unsigned _sp = 0; while (cond) { __builtin_amdgcn_s_sleep(1); \
    if ((++_sp & 255u) == 0u) { if (xb_ld(&(bar)[XB_TMO])) break; if (_sp > XB_SPIN_CAP) { atomicAdd(&(bar)[XB_TMO], 1u); break; } } } } while (0)

struct XcdBarrier {
    unsigned* bar; unsigned x;
    volatile LAS unsigned* st;
};

__device__ __forceinline__ XcdBarrier xcd_barrier_post(unsigned* bar, volatile LAS unsigned* st) {
    XcdBarrier b; b.bar = bar; b.x = xb_xcc_id(); b.st = st;
    if (threadIdx.x == 0) (void)xb_add(&bar[XB_XCNT(b.x)], 1u);
    return b;
}
__device__ __forceinline__ void xcd_barrier_complete(unsigned* bar, unsigned x, unsigned& nloc, unsigned& nx) {
    const unsigned G = gridDim.x * gridDim.y * gridDim.z;
    unsigned sum, cnt, mine, sp = 0u;
    for (;;) {
        sum = 0u; cnt = 0u; mine = 0u;
#pragma unroll
        for (unsigned j = 0; j < 16; ++j) { const unsigned c = xb_ld(&bar[XB_XCNT(j)]); sum += c; cnt += (c > 0u) ? 1u : 0u; mine = (j == x) ? c : mine; }
        if (sum == G) break;
        __builtin_amdgcn_s_sleep(1);
        if ((++sp & 255u) == 0u) { if (xb_ld(&bar[XB_TMO])) break; if (sp > XB_SPIN_CAP) { atomicAdd(&bar[XB_TMO], 1u); break; } }
    }
    nloc = mine > 0u ? mine : 1u; nx = cnt > 0u ? cnt : 1u;
}

__device__ __forceinline__ void xcd_barrier(const XcdBarrier& b) {
    asm volatile("s_waitcnt vmcnt(0)" ::: "memory");
    __syncthreads();
    if (threadIdx.x == 0) {
        unsigned* bar = b.bar;
        __builtin_amdgcn_s_waitcnt(0);
        unsigned nloc = b.st[0], nx = b.st[1];
        if (nloc == 0u) { xcd_barrier_complete(bar, b.x, nloc, nx); b.st[0] = nloc; b.st[1] = nx; }
        const unsigned old = xb_add(&bar[XB_XSUB(b.x)], 1u);
        const unsigned gen = old / nloc;
        if (old + 1u == (gen + 1u) * nloc) {
            __builtin_amdgcn_fence(__ATOMIC_RELEASE, "agent");
            asm volatile("s_waitcnt vmcnt(0)" ::: "memory");
            const unsigned og = xb_add(&bar[XB_TOP], 1u);
            const unsigned tg = og / nx;
            if (og + 1u == (tg + 1u) * nx) xb_add(&bar[XB_TOPGEN], 1u);
            else XB_SPIN(xb_ld(&bar[XB_TOPGEN]) == tg, bar);
            __builtin_amdgcn_fence(__ATOMIC_ACQUIRE, "agent");
            xb_add(&bar[XB_XGEN(b.x)], 1u);
            asm volatile("s_waitcnt vmcnt(0)" ::: "memory");
        } else {
            XB_SPIN(xb_ld(&bar[XB_XGEN(b.x)]) == gen, bar);
            __builtin_amdgcn_fence(__ATOMIC_ACQUIRE, "agent");
            asm volatile("s_waitcnt vmcnt(0)" ::: "memory");
        }
    }
    __syncthreads();
}

using pg8::bf16_t; using pg8::bf16x8; using pg8::f32x4; using pg8::u32x4; using pg8::u32x2;
using pg8::L_TOK; using pg8::MPAD; using pg8::DMODEL; using pg8::DINP; using pg8::GWID; using pg8::PW; using pg8::PCH;
using pg8::PC_GLU; using pg8::PC_CG; using pg8::PC_SCSX; using pg8::PC_GB; using pg8::PC_Q; using pg8::PC_K; using pg8::PC_V; using pg8::PC_AG; using pg8::PC_PI; using pg8::PC_PG;
using pg8::silu_f; using pg8::sigm_f; using pg8::bflo; using pg8::bfhi; using pg8::cvt_pk_bf16;
typedef float f32x16 __attribute__((ext_vector_type(16)));
typedef short s16x4 __attribute__((ext_vector_type(4)));

constexpr int NTHR = 512, NLAYER = 4;
constexpr int LDS_BYTES = 147456, MISC_OFF = 131072;
constexpr int MISC_Q = 4, MISC_DONE = 5;
constexpr int MISC_STAT = 256, MISC_FIN = 2560;

constexpr size_t AL256(size_t x) { return (x + 255) & ~(size_t)255; }
constexpr size_t WS_CTL = 0;
constexpr size_t CTL_BYTES = 65536;
constexpr size_t SZ_WIN_L = (size_t)DINP * DMODEL * 2, SZ_WOUT_L = (size_t)DMODEL * DMODEL * 2, SZ_WPW_L = (size_t)GWID * GWID * 2, SZ_WPOOL_L = (size_t)4 * 256 * 256 * 2;
constexpr size_t WS_WIN = WS_CTL + CTL_BYTES;
constexpr size_t WS_WOUT = WS_WIN + NLAYER * SZ_WIN_L;
constexpr size_t WS_WPW = WS_WOUT + NLAYER * SZ_WOUT_L;
constexpr size_t WS_WPOOL = WS_WPW + NLAYER * SZ_WPW_L;
constexpr size_t WS_H = WS_WPOOL + NLAYER * SZ_WPOOL_L;
constexpr size_t WS_HB = WS_H + (size_t)MPAD * DMODEL * 4;
constexpr size_t WS_SSQ = WS_HB + (size_t)MPAD * DMODEL * 2;
constexpr size_t WS_SSQT = WS_SSQ + (size_t)MPAD * 64 * 4;
constexpr size_t WS_P = WS_SSQT + 16 * 256 * 4;
constexpr size_t WS_ALN = WS_P + (size_t)MPAD * DINP * 2;
constexpr size_t WS_QN = WS_ALN + (size_t)MPAD * GWID * 2;
constexpr size_t WS_KN = WS_QN + (size_t)MPAD * GWID * 2;
constexpr size_t WS_POOLED = WS_KN + (size_t)MPAD * GWID * 2;
constexpr size_t WS_YCAT = WS_POOLED + (size_t)MPAD * GWID * 2;
constexpr size_t WS_END = WS_YCAT + (size_t)MPAD * DMODEL * 2;
constexpr int CW_BAR = 0;
constexpr int CW_QUEUE = 4096;
constexpr int CW_CONVQ = 10240;
constexpr int CW_PREPQ = 8192, CW_RDY = 8704, CW_THIN = 9216;

__device__ __forceinline__ float wave_sum(float v) {
#pragma unroll
    for (int o = 32; o >= 1; o >>= 1) v += __shfl_xor(v, o);
    return v;
}

struct Args { const float* in[15]; float* out; unsigned char* ws; int ph_lo, ph_hi; };
typedef const __attribute__((address_space(4))) Args* KArgP;
struct Frame {
    LAS unsigned char* lds; volatile LAS unsigned* misc; int tid, lane, wave, G; KArgP kp;
    __device__ __forceinline__ void refresh() { int t = threadIdx.x; asm volatile("" : "+v"(t)); tid = t; lane = t & 63; wave = __builtin_amdgcn_readfirstlane(t >> 6); }
};
__device__ __forceinline__ KArgP kargs(const Frame& F) { KArgP p = F.kp; asm volatile("" : "+s"(p)); return p; }
#define KIN(i) (kargs(F)->in[i])
#define KWS (kargs(F)->ws)
#define KCTL ((unsigned*)(kargs(F)->ws + WS_CTL))

constexpr int CU_IN = 32 * 52, CU_OUT = 32 * 16, CU_PW = 8 * 4, CU_POOL = 4 * 2, CU_L = CU_IN + CU_OUT + CU_PW + CU_POOL;
struct TrJob { const float* src; const float* scale; bf16_t* dst; int K, N, k0, n0, perm; };
__device__ __forceinline__ TrJob tr_decode(const Frame& F, int l, int r) {
    TrJob j; j.scale = nullptr; j.perm = 0;
    if (r < CU_IN) { j.perm = 1; j.src = KIN(3) + (size_t)l * DMODEL * DINP; j.scale = KIN(2) + l * DMODEL; j.dst = (bf16_t*)(KWS + WS_WIN + l * SZ_WIN_L); j.K = DMODEL; j.N = DINP; j.k0 = (r / 104) * 256; j.n0 = (r % 104) * 128; }
    else if (r < CU_IN + CU_OUT) { r -= CU_IN; j.src = KIN(14) + (size_t)l * DMODEL * DMODEL; j.dst = (bf16_t*)(KWS + WS_WOUT + l * SZ_WOUT_L); j.K = DMODEL; j.N = DMODEL; j.k0 = (r / 32) * 256; j.n0 = (r % 32) * 128; }
    else if (r < CU_IN + CU_OUT + CU_PW) { r -= CU_IN + CU_OUT; j.src = KIN(8) + (size_t)l * GWID * GWID; j.dst = (bf16_t*)(KWS + WS_WPW + l * SZ_WPW_L); j.K = GWID; j.N = GWID; j.k0 = (r / 8) * 256; j.n0 = (r % 8) * 128; }
    else { r -= CU_IN + CU_OUT + CU_PW; const int g = r >> 1; j.src = KIN(12) + (size_t)(l * 4 + g) * 65536; j.dst = (bf16_t*)(KWS + WS_WPOOL + l * SZ_WPOOL_L) + (size_t)g * 65536; j.K = 256; j.N = 256; j.k0 = 0; j.n0 = (r & 1) * 128; }
    return j;
}
template <bool NT> __device__ __forceinline__ f32x4 ldg4(const float* p) { if (NT) return __builtin_nontemporal_load((const f32x4*)p); else return *(const f32x4*)p; }
template <bool NT> __device__ __forceinline__ void stg4(bf16_t* p, u32x4 v) { if (NT) __builtin_nontemporal_store(v, (u32x4*)p); else *(u32x4*)p = v; }
__device__ __forceinline__ void conv_issue(const Frame& F, int l, int r, int lane, int wave, f32x4 (&Rx)[4][2][2], float (&Rsc)[4][2]) {
    const TrJob j = tr_decode(F, l, r);
    const int i = lane & 15, g = lane >> 4, krow = 8 * (i >> 2) + (i & 3);
    const float* sp = j.src + (size_t)(j.k0 + 128 * (wave >> 2) + krow) * j.N + j.n0 + 32 * (wave & 3) + 4 * g;
#pragma unroll
    for (int kb = 0; kb < 4; ++kb)
#pragma unroll
        for (int h = 0; h < 2; ++h) { const float* p = sp + (size_t)(32 * kb + 4 * h) * j.N; Rx[kb][h][0] = *(const f32x4*)p; Rx[kb][h][1] = *(const f32x4*)(p + 16);
            Rsc[kb][h] = j.scale ? j.scale[j.k0 + 128 * (wave >> 2) + krow + 32 * kb + 4 * h] : 1.0f; }
}
__device__ __forceinline__ void conv_finish(const Frame& F, int l, int r, int lane, int wave, const f32x4 (&Rx)[4][2][2], const float (&Rsc)[4][2]) {
    const TrJob j = tr_decode(F, l, r);
    const int i = lane & 15, g = lane >> 4;
    u32x4 b0 = {0u, 0u, 0u, 0u}, b1 = {0u, 0u, 0u, 0u};
    { const int e = i - 4 * g;
      if (e >= 0 && e < 4) { const unsigned one = (e & 1) ? 0x3F800000u : 0x00003F80u; if (e < 2) { b0.x = one; b1.z = one; } else { b0.y = one; b1.w = one; } } }
    const bf16x8 B0 = *reinterpret_cast<const bf16x8*>(&b0), B1 = *reinterpret_cast<const bf16x8*>(&b1);
    const int nsrc = j.n0 + 32 * (wave & 3), ndst = j.perm ? pg8::win_dst_blk(nsrc >> 7) * 128 + (nsrc & 127) : nsrc;
    bf16_t* dp = j.dst + (size_t)(ndst + i) * j.K + j.k0 + 128 * (wave >> 2) + 8 * g;
#pragma unroll
    for (int kb = 0; kb < 4; ++kb) {
        bf16x8 A[2];
#pragma unroll
        for (int h = 0; h < 2; ++h) { const f32x4 lo = Rx[kb][h][0] * Rsc[kb][h], hi = Rx[kb][h][1] * Rsc[kb][h];
            u32x4 w; w.x = cvt_pk_bf16(lo[0], lo[1]); w.y = cvt_pk_bf16(lo[2], lo[3]); w.z = cvt_pk_bf16(hi[0], hi[1]); w.w = cvt_pk_bf16(hi[2], hi[3]);
            A[h] = *reinterpret_cast<const bf16x8*>(&w); }
        const f32x4 z = {0.f, 0.f, 0.f, 0.f};
        const f32x4 c00 = __builtin_amdgcn_mfma_f32_16x16x32_bf16(A[0], B0, z, 0, 0, 0), c10 = __builtin_amdgcn_mfma_f32_16x16x32_bf16(A[1], B0, z, 0, 0, 0);
        const f32x4 c01 = __builtin_amdgcn_mfma_f32_16x16x32_bf16(A[0], B1, z, 0, 0, 0), c11 = __builtin_amdgcn_mfma_f32_16x16x32_bf16(A[1], B1, z, 0, 0, 0);
        u32x4 w0, w1;
#define PK2(lo, hi) __builtin_amdgcn_perm(__float_as_uint(hi), __float_as_uint(lo), 0x07060302u)
        w0.x = PK2(c00[0], c00[1]); w0.y = PK2(c00[2], c00[3]); w0.z = PK2(c10[0], c10[1]); w0.w = PK2(c10[2], c10[3]);
        w1.x = PK2(c01[0], c01[1]); w1.y = PK2(c01[2], c01[3]); w1.z = PK2(c11[0], c11[1]); w1.w = PK2(c11[2], c11[3]);
#undef PK2
        *(u32x4*)(dp + 32 * kb) = w0; *(u32x4*)(dp + (size_t)16 * j.K + 32 * kb) = w1;
    }
}
template <bool NT> __device__ __forceinline__ void convert_units(const Frame& F0, int l, int first, int stride, int count) {
    if (count <= 0) return;
    Frame F = F0; F.refresh();
    const int lane = F.lane, wave = F.wave;
    f32x4 xa[4][2][2]; float sa[4][2]; f32x4 xb[4][2][2]; float sb[4][2];
    conv_issue(F, l, first, lane, wave, xa, sa);
    int k = 0;
#pragma unroll 1
    while (k + 2 < count) {
        conv_issue(F, l, first + stride * (k + 1), lane, wave, xb, sb);
        conv_finish(F, l, first + stride * k, lane, wave, xa, sa);
        conv_issue(F, l, first + stride * (k + 2), lane, wave, xa, sa);
        conv_finish(F, l, first + stride * (k + 1), lane, wave, xb, sb);
        k += 2;
    }
    if (count - k == 2) {
        conv_issue(F, l, first + stride * (k + 1), lane, wave, xb, sb);
        conv_finish(F, l, first + stride * k, lane, wave, xa, sa);
        conv_finish(F, l, first + stride * (k + 1), lane, wave, xb, sb);
    } else conv_finish(F, l, first + stride * k, lane, wave, xa, sa);
}
__device__ __forceinline__ void p0_prologue(const Frame& F0) {
    Frame F = F0; F.refresh();
    convert_units<false>(F, 0, (int)blockIdx.x, F.G, (CU_L - (int)blockIdx.x + F.G - 1) / F.G);
    {
        const float* x = KIN(0); const float* meta = KIN(1);
        bf16_t* HB = (bf16_t*)(KWS + WS_HB); float* SSQ = (float*)(KWS + WS_SSQ);
        for (int r = blockIdx.x * 8 + F.wave; r < MPAD; r += F.G * 8) {
            float ss = 0.f;
            if (r < L_TOK) {
                const float* src = r < 16 ? meta + (size_t)r * DMODEL : x + (size_t)(r - 16) * DMODEL;
#pragma unroll 4
                for (int i = 0; i < 16; ++i) { const int c = 4 * (F.lane + 64 * i); const f32x4 vv = *(const f32x4*)(src + c);
                    ss += (vv[0] * vv[0] + vv[1] * vv[1]) + (vv[2] * vv[2] + vv[3] * vv[3]);
                    u32x2 w; w.x = cvt_pk_bf16(vv[0], vv[1]); w.y = cvt_pk_bf16(vv[2], vv[3]); *(u32x2*)(HB + (size_t)r * DMODEL + c) = w; }
                ss = wave_sum(ss);
            } else {
#pragma unroll 4
                for (int i = 0; i < 16; ++i) { const int c = 4 * (F.lane + 64 * i);
                    u32x2 w; w.x = 0u; w.y = 0u; *(u32x2*)(HB + (size_t)r * DMODEL + c) = w; }
            }
            SSQ[(size_t)r * 64 + F.lane] = (F.lane == 0) ? ss : 0.f;
            if (r >= 8192 && r < 8208) { float* T = (float*)(KWS + WS_SSQT) + (r - 8192) * 256;
#pragma unroll
                for (int i = 0; i < 4; ++i) T[F.lane + 64 * i] = (F.lane == 0 && i == 0) ? ss : 0.f; }
        }
    }
}

constexpr int PT = 34, PH = 17, PSTRIDE = 33, PREP_TILES = (MPAD + PSTRIDE - 1) / PSTRIDE;
constexpr float QSCALE = 0.08838834764831845f * 1.4426950408889634f;
constexpr int RW = PW / 2;
__device__ __forceinline__ int clampt(int t) { return t < 0 ? 0 : (t > MPAD - 1 ? MPAD - 1 : t); }
template <int W> __device__ __forceinline__ void pool_part(const unsigned* xp, unsigned* op, int t0) {
    unsigned xs[PT + W - 1];
#pragma unroll
    for (int i = 0; i < PT + W - 1; ++i) xs[i] = xp[(size_t)clampt(t0 - (W - 1) + i) * 512];
    float S0 = 0.f, S1 = 0.f;
#pragma unroll
    for (int i = 0; i < W - 1; ++i) { if (t0 - (W - 1) + i >= 0) { S0 += bflo(xs[i]); S1 += bfhi(xs[i]); } }
#pragma unroll
    for (int j = 0; j < PT; ++j) { const int t = t0 + j; const float x0 = bflo(xs[W - 1 + j]), x1 = bfhi(xs[W - 1 + j]);
        S0 += x0; S1 += x1;
        const int cnt = (t + 1 < W) ? (t + 1) : W; const float ic = 1.0f / (float)cnt;
        if (t < MPAD && j < PSTRIDE) op[(size_t)j * 128] = cvt_pk_bf16(S0 * ic - x0, S1 * ic - x1);
        if (t - W + 1 >= 0) { S0 -= bflo(xs[j]); S1 -= bfhi(xs[j]); } }
}
__device__ __forceinline__ void prep_tile(const Frame& F0, int l, int tile_in) {
    Frame F = F0; F.refresh();
    const int tile = __builtin_amdgcn_readfirstlane(tile_in);
    const int tid = F.tid, lane = F.lane, wave = F.wave;
    unsigned char* const ws = KWS;
    const unsigned* P32 = (const unsigned*)(ws + WS_P);
    LAS unsigned* glu = (LAS unsigned*)F.lds;
    LAS float* stat = (LAS float*)(F.lds + MISC_OFF + MISC_STAT);
    LAS float* fin = (LAS float*)(F.lds + MISC_OFF + MISC_FIN);
    {
        const int t0 = tile * PSTRIDE;
#pragma unroll 1
        for (int rb = 0; rb < 4; ++rb) {
            unsigned ca[16];
#pragma unroll
            for (int i = 0; i < 16; ++i) ca[i] = P32[((size_t)PC_GLU * MPAD + clampt(t0 - 30 + 16 * rb + i)) * 512 + tid];
#pragma unroll
            for (int i = 0; i < 16; ++i) { const int t = t0 - 30 + 16 * rb + i;
                glu[(16 * rb + i) * 512 + tid] = (t < 0 || t >= MPAD) ? 0u : ca[i]; }
        }
        __syncthreads();
        {
            const float* dw = KIN(4) + (size_t)l * 31 * GWID + 2 * tid;
            float w[31][2];
#pragma unroll
            for (int k = 0; k < 31; ++k) { const float2 ww = *(const float2*)(dw + k * GWID); w[k][0] = ww.x; w[k][1] = ww.y; }
            const float2 cb2 = *(const float2*)(KIN(5) + l * GWID + 2 * tid);
            const float2 gg = *(const float2*)(KIN(6) + l * GWID + 2 * tid), bb = *(const float2*)(KIN(7) + l * GWID + 2 * tid);
            unsigned* alnp = (unsigned*)(ws + WS_ALN) + (size_t)t0 * 512 + tid;
#pragma unroll 1
            for (int blk = 0; blk < 2; ++blk) {
                float acc[PH][2];
#pragma unroll
                for (int j = 0; j < PH; ++j) { acc[j][0] = cb2.x; acc[j][1] = cb2.y; }
                const LAS unsigned* gb = glu + (PH * blk) * 512 + tid;
#pragma unroll
                for (int r = 0; r < PH + 30; ++r) { const unsigned u = gb[r * 512]; const float g0 = bflo(u), g1 = bfhi(u);
#pragma unroll
                    for (int j = 0; j < PH; ++j) { const int k = r - j; if (k >= 0 && k <= 30) { acc[j][0] = fmaf(w[k][0], g0, acc[j][0]); acc[j][1] = fmaf(w[k][1], g1, acc[j][1]); } } }
#pragma unroll
                for (int j = 0; j < PH; ++j) { const float s1 = wave_sum(acc[j][0] + acc[j][1]), s2 = wave_sum(acc[j][0] * acc[j][0] + acc[j][1] * acc[j][1]);
                    if (lane == 0) { stat[(j * 8 + wave) * 2] = s1; stat[(j * 8 + wave) * 2 + 1] = s2; } }
                __syncthreads();
                if (tid < PH) { float s1 = 0.f, s2 = 0.f;
#pragma unroll
                    for (int wv = 0; wv < 8; ++wv) { s1 += stat[(tid * 8 + wv) * 2]; s2 += stat[(tid * 8 + wv) * 2 + 1]; }
                    const float mean = s1 * (1.0f / 1024.0f), var = fmaxf(s2 * (1.0f / 1024.0f) - mean * mean, 0.f);
                    fin[tid * 2] = mean; fin[tid * 2 + 1] = __builtin_amdgcn_rsqf(var + 1e-6f); }
                __syncthreads();
#pragma unroll
                for (int j = 0; j < PH; ++j) { const int t = t0 + PH * blk + j; const float mean = fin[j * 2], rs = fin[j * 2 + 1];
                    const float y0 = (acc[j][0] - mean) * rs * gg.x + bb.x, y1 = (acc[j][1] - mean) * rs * gg.y + bb.y;
                    if (t < MPAD && PH * blk + j < PSTRIDE) alnp[(size_t)(PH * blk + j) * 512] = cvt_pk_bf16(silu_f(y0), silu_f(y1)); }
            }
        }
        {
            const float* scw = KIN(9) + (size_t)l * 3 * GWID + 2 * tid;
            const float2 w0 = *(const float2*)(scw), w1 = *(const float2*)(scw + GWID), w2 = *(const float2*)(scw + 2 * GWID);
            unsigned* yp = (unsigned*)(ws + WS_YCAT) + (size_t)t0 * (DMODEL / 2) + 512 + tid;
#pragma unroll 1
            for (int hf = 0; hf < 2; ++hf) {
                const int tb = t0 + PH * hf;
                unsigned usc[PH + 2], usb[PH];
#pragma unroll
                for (int i = 0; i < PH + 2; ++i) usc[i] = P32[((size_t)PC_SCSX * MPAD + clampt(tb - 2 + i)) * 512 + tid];
#pragma unroll
                for (int i = 0; i < PH; ++i) usb[i] = P32[((size_t)PC_GB * MPAD + clampt(tb + i)) * 512 + tid];
                float pr[PH + 2][2];
#pragma unroll
                for (int i = 0; i < PH + 2; ++i) { const bool ok = (tb - 2 + i >= 0); pr[i][0] = ok ? bflo(usc[i]) : 0.f; pr[i][1] = ok ? bfhi(usc[i]) : 0.f; }
#pragma unroll
                for (int i = 0; i < PH; ++i) {
                    const float cv0 = w0.x * pr[i][0] + w1.x * pr[i + 1][0] + w2.x * pr[i + 2][0], cv1 = w0.y * pr[i][1] + w1.y * pr[i + 1][1] + w2.y * pr[i + 2][1];
                    if (tb + i < MPAD && PH * hf + i < PSTRIDE) yp[(size_t)(PH * hf + i) * (DMODEL / 2)] = cvt_pk_bf16(bflo(usb[i]) * cv0, bfhi(usb[i]) * cv1); }
            }
        }
        {
            const int gi = __builtin_amdgcn_readfirstlane(tid >> 7);
            const unsigned* xp = P32 + (size_t)PC_PI * MPAD * 512 + tid;
            unsigned* op = (unsigned*)(ws + WS_POOLED) + ((size_t)gi * MPAD + t0) * 128 + (tid & 127);
            if (gi == 0) pool_part<2>(xp, op, t0); else if (gi == 1) pool_part<4>(xp, op, t0); else if (gi == 2) pool_part<8>(xp, op, t0); else pool_part<16>(xp, op, t0);
        }
        __syncthreads();
    }
}

__device__ __forceinline__ void publish_add(unsigned* ctr) {
    asm volatile("s_waitcnt vmcnt(0)" ::: "memory");
    __syncthreads();
    if (threadIdx.x == 0) {
        __builtin_amdgcn_fence(__ATOMIC_RELEASE, "agent");
        asm volatile("s_waitcnt vmcnt(0)" ::: "memory");
        (void)xb_add(ctr, 1u);
    }
}
__device__ __forceinline__ void wait_count(const Frame& F, unsigned* ctr, unsigned need) {
    if (threadIdx.x == 0) {
        unsigned* bar = KCTL + CW_BAR;
        XB_SPIN(xb_ld(ctr) < need, bar);
        __builtin_amdgcn_fence(__ATOMIC_ACQUIRE, "agent");
        asm volatile("s_waitcnt vmcnt(0)" ::: "memory");
    }
    __syncthreads();
}
__device__ __forceinline__ void prep_queue(const Frame& F0, int l) {
    Frame F = F0; F.refresh();
    unsigned* head = KCTL + CW_PREPQ + 64 * l;
    bool got_main = false, got_thin = false;
    for (;;) {
        if (F.tid == 0) F.misc[MISC_Q] = __hip_atomic_fetch_add(head, 1u, __ATOMIC_RELAXED, __HIP_MEMORY_SCOPE_AGENT);
        __syncthreads();
        const unsigned u = F.misc[MISC_Q];
        __syncthreads();
        if (u >= (unsigned)PREP_TILES) break;
        if (!got_main) { wait_count(F, KCTL + CW_RDY + 64 * l, (unsigned)F.G); got_main = true; }
        if (!got_thin && (int)u * PSTRIDE + PSTRIDE >= 8192) { wait_count(F, KCTL + CW_THIN + 64 * l, 104u); got_thin = true; }
        prep_tile(F, l, (int)u);
    }
}

#ifndef ATTN_EARLY_EXIT
#define ATTN_EARLY_EXIT 1
#endif
constexpr int A_KBUF = 16384, A_VSTRIDE = 320, A_VBUF = 64 * A_VSTRIDE, A_VOFF = 2 * A_KBUF;
#define KSWZ(row, colB) ((row) * 256 + ((colB) ^ (((row) & 7) << 4)))
template <int OFF> __device__ __forceinline__ s16x4 tr_read(unsigned vb) {
    s16x4 r; asm volatile("ds_read_b64_tr_b16 %0, %1 offset:%2" : "=&v"(r) : "v"(vb), "i"(OFF) : "memory"); return r;
}
__device__ __forceinline__ int crow(int r, int hi) { return (r & 3) + 8 * (r >> 2) + 4 * hi; }

template <int SBLK>
__device__ __forceinline__ void sb_block(const f32x16& pz, f32x16 (&o)[4], float& Cw, const int hi, const unsigned vb) {
    float sg[16], om[16];
#pragma unroll
    for (int r = 0; r < 16; ++r) { const float z = pz[r];
        const float e = __builtin_amdgcn_exp2f(-z), rc = __builtin_amdgcn_rcpf(1.0f + e); sg[r] = rc; om[r] = e * rc; }
    float a[16];
#pragma unroll
    for (int i = 3; i >= 0; --i) {
        const float x2 = om[4 * i + 3], x1 = x2 * om[4 * i + 2], x0 = x1 * om[4 * i + 1], R = x0 * om[4 * i];
        const auto rr = __builtin_amdgcn_permlane32_swap(__float_as_uint(R), __float_as_uint(R), false, false);
        const float R0 = __uint_as_float(rr[0]), R1 = __uint_as_float(rr[1]);
        const float base = hi ? Cw : Cw * R1;
        a[4 * i + 3] = sg[4 * i + 3] * base; a[4 * i + 2] = sg[4 * i + 2] * (base * x2); a[4 * i + 1] = sg[4 * i + 1] * (base * x1); a[4 * i] = sg[4 * i] * (base * x0);
        Cw = Cw * (R0 * R1);
    }
    u32x4 w0, w1;
    w0.x = cvt_pk_bf16(a[0], a[1]); w0.y = cvt_pk_bf16(a[2], a[3]); w0.z = cvt_pk_bf16(a[4], a[5]); w0.w = cvt_pk_bf16(a[6], a[7]);
    w1.x = cvt_pk_bf16(a[8], a[9]); w1.y = cvt_pk_bf16(a[10], a[11]); w1.z = cvt_pk_bf16(a[12], a[13]); w1.w = cvt_pk_bf16(a[14], a[15]);
    const bf16x8 pf0 = *reinterpret_cast<const bf16x8*>(&w0), pf1 = *reinterpret_cast<const bf16x8*>(&w1);
#define PVBLK(DB) do { \
        const s16x4 l0 = tr_read<(32 * SBLK + 0) * A_VSTRIDE + 64 * (DB)>(vb), h0 = tr_read<(32 * SBLK + 8) * A_VSTRIDE + 64 * (DB)>(vb); \
        const s16x4 l1 = tr_read<(32 * SBLK + 16) * A_VSTRIDE + 64 * (DB)>(vb), h1 = tr_read<(32 * SBLK + 24) * A_VSTRIDE + 64 * (DB)>(vb); \
        asm volatile("s_waitcnt lgkmcnt(0)" ::: "memory"); __builtin_amdgcn_sched_barrier(0); \
        o[DB] = __builtin_amdgcn_mfma_f32_32x32x16_bf16((bf16x8){l0[0], l0[1], l0[2], l0[3], h0[0], h0[1], h0[2], h0[3]}, pf0, o[DB], 0, 0, 0); \
        o[DB] = __builtin_amdgcn_mfma_f32_32x32x16_bf16((bf16x8){l1[0], l1[1], l1[2], l1[3], h1[0], h1[1], h1[2], h1[3]}, pf1, o[DB], 0, 0, 0); } while (0)
    PVBLK(0); PVBLK(1); PVBLK(2); PVBLK(3);
#undef PVBLK
}

__device__ __forceinline__ void attn_unit(const Frame& F, int hd, int qstart, int nq) {
    const int tid = F.tid, wid = F.wave, lane = F.lane, r32 = lane & 31, hi = lane >> 5;
    LAS unsigned char* lds = F.lds;
    const bf16_t* Qh = (const bf16_t*)(KWS + WS_P) + PC_Q * PCH + hd * 128; const bf16_t* Kh = (const bf16_t*)(KWS + WS_P) + PC_K * PCH + hd * 128;
    const bf16_t* Pm = (const bf16_t*)(KWS + WS_P); const bf16_t* Vh = Pm + PC_V * PCH + hd * 128;
    bf16_t* Y = (bf16_t*)(KWS + WS_YCAT);
    const int qend = qstart + nq;
    const int q0w = qstart + 32 * wid, myq = q0w + r32;
    bf16x8 qr[8];
    { const bf16_t* qp = Qh + (size_t)myq * GWID + hi * 8;
#pragma unroll
      for (int d0 = 0; d0 < 8; ++d0) qr[d0] = *(const bf16x8*)(qp + d0 * 16); }
    f32x16 o[4];
#pragma unroll
    for (int d = 0; d < 4; ++d)
#pragma unroll
        for (int r = 0; r < 16; ++r) o[d][r] = 0.f;
    float Cw = 1.0f;
    const int jt_hi = (qstart + nq - 2) >> 6;
    const int sr = tid >> 4, sc = (tid & 15) * 8;
    const unsigned vbase = (unsigned)(size_t)(lds + A_VOFF) + (unsigned)((4 * hi + ((lane & 15) >> 2)) * A_VSTRIDE + (16 * ((lane >> 4) & 1) + 4 * (lane & 3)) * 2);
    u32x4 gk0, gk1, gv0, gv1;
#define ALOAD(jt) do { const size_t kr = (size_t)(64 * (jt) + sr); \
        gk0 = *(const u32x4*)(Kh + kr * GWID + sc); gk1 = *(const u32x4*)(Kh + (kr + 32) * GWID + sc); \
        gv0 = *(const u32x4*)(Vh + kr * GWID + sc); gv1 = *(const u32x4*)(Vh + (kr + 32) * GWID + sc); } while (0)
#define AWRITE(b) do { *(LAS u32x4*)(lds + (b) * A_KBUF + KSWZ(sr, sc * 2)) = gk0; *(LAS u32x4*)(lds + (b) * A_KBUF + KSWZ(sr + 32, sc * 2)) = gk1; \
        *(LAS u32x4*)(lds + A_VOFF + (b) * A_VBUF + sr * A_VSTRIDE + sc * 2) = gv0; *(LAS u32x4*)(lds + A_VOFF + (b) * A_VBUF + (sr + 32) * A_VSTRIDE + sc * 2) = gv1; } while (0)
    if (tid == 0) F.misc[MISC_DONE] = (unsigned)(8 - ((nq + 31) >> 5));
    ALOAD(jt_hi); AWRITE(0);
    __syncthreads();
    bool wdone = (32 * wid >= nq);
    for (int it = 0;; ++it) {
        const int jt = jt_hi - it, cur = it & 1; const bool more = jt > 0;
        if (more) ALOAD(jt - 1);
        const int tlo = 64 * jt;
        if (!wdone && tlo <= q0w + 30) {
            const bool need_mask = (tlo + 63 >= q0w);
            const LAS unsigned char* Kb = lds + cur * A_KBUF;
            f32x16 p0, p1;
#pragma unroll
            for (int r = 0; r < 16; ++r) { p0[r] = 0.f; p1[r] = 0.f; }
#pragma unroll
            for (int d0 = 0; d0 < 8; ++d0) { const int cb = (d0 * 16 + hi * 8) * 2;
                const bf16x8 b0 = *(const LAS bf16x8*)(Kb + KSWZ(r32, cb)), b1 = *(const LAS bf16x8*)(Kb + KSWZ(32 + r32, cb));
                p0 = __builtin_amdgcn_mfma_f32_32x32x16_bf16(b0, qr[d0], p0, 0, 0, 0);
                p1 = __builtin_amdgcn_mfma_f32_32x32x16_bf16(b1, qr[d0], p1, 0, 0, 0); }
            const unsigned vb = vbase + (unsigned)(cur * A_VBUF);
            if (need_mask) {
#pragma unroll
                for (int r = 0; r < 16; ++r) { const int key = tlo + crow(r, hi); p0[r] = (key < myq) ? p0[r] : -120.f; p1[r] = (key + 32 < myq) ? p1[r] : -120.f; }
            }
            sb_block<1>(p1, o, Cw, hi, vb);
            sb_block<0>(p0, o, Cw, hi, vb);
#if ATTN_EARLY_EXIT
            if (__all(Cw < 1e-37f)) { wdone = true; if (lane == 0) __hip_atomic_fetch_add((LAS unsigned*)(F.lds + MISC_OFF) + MISC_DONE, 1u, __ATOMIC_RELAXED, __HIP_MEMORY_SCOPE_WORKGROUP); }
#endif
        }
        if (more) AWRITE(cur ^ 1);
        __syncthreads();
        if (!more) break;
#if ATTN_EARLY_EXIT
        if (F.misc[MISC_DONE] == 8u) break;
#endif
    }
#undef ALOAD
#undef AWRITE
    if (myq < qend) {
        const bf16_t* gp = Pm + PC_AG * PCH + (size_t)myq * GWID + hd * 128; bf16_t* yp = Y + (size_t)myq * DMODEL + 2 * GWID + hd * 128;
#pragma unroll
        for (int db = 0; db < 4; ++db)
#pragma unroll
            for (int i = 0; i < 4; ++i) { const int d0 = 32 * db + 8 * i + 4 * hi; const u32x2 gt = *(const u32x2*)(gp + d0);
                u32x2 w; w.x = cvt_pk_bf16(o[db][4 * i] * bflo(gt.x), o[db][4 * i + 1] * bfhi(gt.x));
                w.y = cvt_pk_bf16(o[db][4 * i + 2] * bflo(gt.y), o[db][4 * i + 3] * bfhi(gt.y));
                *(u32x2*)(yp + d0) = w; }
    }
}
constexpr int ATTN_FULL = 8 * 32, ATTN_UNITS = ATTN_FULL + 8;
__device__ __forceinline__ void attn_phase(const Frame& F0, int l) {
    Frame F = F0; F.refresh();
    unsigned* head = KCTL + CW_QUEUE + 64 * l;
    for (;;) {
        if (F.tid == 0) F.misc[MISC_Q] = __hip_atomic_fetch_add(head, 1u, __ATOMIC_RELAXED, __HIP_MEMORY_SCOPE_AGENT);
        __syncthreads();
        const unsigned u = (unsigned)__builtin_amdgcn_readfirstlane((int)F.misc[MISC_Q]);
        __syncthreads();
        if (u >= (unsigned)ATTN_UNITS) break;
        { const bool full = u < (unsigned)ATTN_FULL; attn_unit(F, full ? (int)(u & 7u) : (int)(u - ATTN_FULL), full ? 16 + 256 * (31 - (int)(u >> 3)) : 0, full ? 256 : 16); }
    }
}

typedef float f32x2v __attribute__((ext_vector_type(2)));
__device__ __forceinline__ void thin_outproj(const Frame& F0, int l, bool last) {
    Frame F = F0; F.refresh();
    const int tid = F.tid, lane = F.lane, wave = F.wave, r = lane & 15, g = lane >> 4;
    unsigned char* const ws = KWS;
    for (int u = blockIdx.x; u < 256; u += F.G) {
        const bf16_t* Ap = (const bf16_t*)(ws + WS_YCAT) + (size_t)(8192 + r) * DMODEL + 512 * wave + 8 * g;
        const bf16_t* Bp = (const bf16_t*)(ws + WS_WOUT + l * SZ_WOUT_L) + (size_t)(16 * u + r) * DMODEL + 512 * wave + 8 * g;
        bf16x8 a[16], b[16];
#pragma unroll
        for (int ks = 0; ks < 16; ++ks) { a[ks] = *(const bf16x8*)(Ap + 32 * ks); b[ks] = *(const bf16x8*)(Bp + 32 * ks); }
        f32x4 acc = (f32x4){0.f, 0.f, 0.f, 0.f};
#pragma unroll
        for (int ks = 0; ks < 16; ++ks) acc = __builtin_amdgcn_mfma_f32_16x16x32_bf16(a[ks], b[ks], acc, 0, 0, 0);
        LAS float* part = (LAS float*)F.lds;
#pragma unroll
        for (int e = 0; e < 4; ++e) part[(wave * 16 + 4 * g + e) * 16 + r] = acc[e];
        __syncthreads();
        if (tid < 256) {
            const int row = tid >> 4, cc = tid & 15;
            float y = 0.f;
#pragma unroll
            for (int wv = 0; wv < 8; ++wv) y += part[(wv * 16 + row) * 16 + cc];
            const size_t off = (size_t)(8192 + row) * DMODEL + 16 * u + cc;
            bf16_t* hbp = (bf16_t*)(ws + WS_HB) + off;
            const float h = __uint_as_float((unsigned)(*hbp) << 16) + y;
            if (last) (kargs(F)->out)[off - (size_t)16 * DMODEL] = h;
            else {
                *hbp = (bf16_t)(cvt_pk_bf16(h, 0.f) & 0xffffu);
                float ss = h * h;
#pragma unroll
                for (int o = 8; o >= 1; o >>= 1) ss += __shfl_xor(ss, o);
                if (cc == 0) ((float*)(ws + WS_SSQT))[row * 256 + u] = ss;
            }
        }
        __syncthreads();
    }
}

__device__ __forceinline__ void thin_inproj(const Frame& F0, int l, int v) {
    Frame F = F0; F.refresh();
    const int tid = F.tid, lane = F.lane, wave = F.wave, r = lane & 15, g = lane >> 4;
    unsigned char* const ws = KWS;
    const int pn = v >> 1, hv = v & 1;
    const bool fused = pn < 24;
    const bf16_t* Ap = (const bf16_t*)(ws + WS_HB) + (size_t)(8192 + r) * DMODEL + 512 * wave + 8 * g;
    const bf16_t* Bp = (const bf16_t*)(ws + WS_WIN + l * SZ_WIN_L) + (size_t)(256 * pn + (fused ? 64 * hv : 128 * hv) + r) * DMODEL + 512 * wave + 8 * g;
    const int hstr = fused ? 128 - 64 : 0;
    f32x4 acc[8];
#pragma unroll
    for (int cb = 0; cb < 8; ++cb) acc[cb] = (f32x4){0.f, 0.f, 0.f, 0.f};
#pragma unroll 1
    for (int kb = 0; kb < 8; ++kb) {
        bf16x8 a[2], b[2][8];
#pragma unroll
        for (int ks = 0; ks < 2; ++ks) { a[ks] = *(const bf16x8*)(Ap + 64 * kb + 32 * ks);
#pragma unroll
            for (int cb = 0; cb < 8; ++cb) b[ks][cb] = *(const bf16x8*)(Bp + (size_t)(16 * cb + (cb >> 2) * hstr) * DMODEL + 64 * kb + 32 * ks); }
#pragma unroll
        for (int ks = 0; ks < 2; ++ks)
#pragma unroll
            for (int cb = 0; cb < 8; ++cb) acc[cb] = __builtin_amdgcn_mfma_f32_16x16x32_bf16(a[ks], b[ks][cb], acc[cb], 0, 0, 0);
    }
    LAS float* part = (LAS float*)F.lds;
#pragma unroll
    for (int cb = 0; cb < 8; ++cb)
#pragma unroll
        for (int e = 0; e < 4; ++e) part[(wave * 16 + 4 * g + e) * 128 + 16 * cb + r] = acc[cb][e];
    __syncthreads();
    {
        const int row = tid >> 5, cp = tid & 31;
        float a0 = 0.f, a1 = 0.f, b0 = 0.f, b1 = 0.f;
#pragma unroll
        for (int wv = 0; wv < 8; ++wv) { const f32x2v p2 = *(const LAS f32x2v*)(part + (wv * 16 + row) * 128 + 2 * cp), q2 = *(const LAS f32x2v*)(part + (wv * 16 + row) * 128 + 64 + 2 * cp);
            a0 += p2[0]; a1 += p2[1]; b0 += q2[0]; b1 += q2[1]; }
        const f32x4 q0 = *(const f32x4*)((const float*)(ws + WS_SSQT) + row * 256 + 8 * cp), q1 = *(const f32x4*)((const float*)(ws + WS_SSQT) + row * 256 + 8 * cp + 4);
        float ss = ((q0[0] + q0[1]) + (q0[2] + q0[3])) + ((q1[0] + q1[1]) + (q1[2] + q1[3]));
#pragma unroll
        for (int o = 16; o >= 1; o >>= 1) ss += __shfl_xor(ss, o);
        const float rstd = __builtin_amdgcn_rsqf(ss * (1.0f / 4096.0f) + 1e-6f);
        a0 *= rstd; a1 *= rstd; b0 *= rstd; b1 *= rstd;
        unsigned* pbase = (unsigned*)(ws + WS_P) + (size_t)(8192 + row) * 512;
#define PROW(cb) (pbase + (size_t)((cb) >> 10) * MPAD * 512 + ((cb) & 1023) / 2)
        if (fused) {
            float r0, r1; int cbase;
            if (pn < 8) { r0 = a0 * sigm_f(b0); r1 = a1 * sigm_f(b1); cbase = PC_GLU * 1024 + 128 * pn; }
            else if (pn < 16) { r0 = a0 * b0; r1 = a1 * b1; cbase = PC_SCSX * 1024 + 128 * (pn - 8); }
            else { r0 = a0 * silu_f(b0); r1 = a1 * silu_f(b1); cbase = PC_GB * 1024 + 128 * (pn - 16); }
            PROW(cbase + 64 * hv)[cp] = cvt_pk_bf16(r0, r1);
        } else {
            const int q = (pn - 24) >> 2, t = (pn - 24) & 3;
            const int chunk = (q == 0) ? PC_CG : (q == 1) ? PC_Q : (q == 2) ? PC_K : (q == 3) ? PC_V : (q == 4) ? PC_AG : (q == 5) ? PC_PI : PC_PG;
            if (q == 0 || q == 4 || q == 6) { a0 = silu_f(a0); a1 = silu_f(a1); b0 = silu_f(b0); b1 = silu_f(b1); }
            if (q == 1 || q == 2) {
                float hs = (a0 * a0 + a1 * a1) + (b0 * b0 + b1 * b1);
#pragma unroll
                for (int o = 16; o >= 1; o >>= 1) hs += __shfl_xor(hs, o);
                float hr = __builtin_amdgcn_rsqf(hs * (1.0f / 128.0f) + 1e-6f); if (q == 1) hr *= QSCALE;
                const float* gp = (q == 1 ? KIN(10) : KIN(11)) + l * 128;
                a0 *= hr * gp[2 * cp]; a1 *= hr * gp[2 * cp + 1]; b0 *= hr * gp[64 + 2 * cp]; b1 *= hr * gp[65 + 2 * cp];
            }
            const int cbase = chunk * 1024 + 256 * t + 128 * hv;
            PROW(cbase)[cp] = cvt_pk_bf16(a0, a1);
            PROW(cbase + 64)[cp] = cvt_pk_bf16(b0, b1);
#undef PROW
        }
    }
    __syncthreads();
}

constexpr int CONV_CHUNK = 4, CONV_CHUNKS = (CU_L + CONV_CHUNK - 1) / CONV_CHUNK;
__device__ __forceinline__ void conv_queue(const Frame& F0, int l, unsigned* head) {
    Frame F = F0; F.refresh();
    for (;;) {
        if (F.tid == 0) F.misc[MISC_Q] = __hip_atomic_fetch_add(head, 1u, __ATOMIC_RELAXED, __HIP_MEMORY_SCOPE_AGENT);
        __syncthreads();
        const int q = __builtin_amdgcn_readfirstlane((int)F.misc[MISC_Q]);
        __syncthreads();
        if (q >= CONV_CHUNKS) break;
        const int first = q * CONV_CHUNK, cnt = (CU_L - first < CONV_CHUNK) ? CU_L - first : CONV_CHUNK;
        convert_units<false>(F, l, first, 1, cnt);
    }
}

constexpr int N_PHASES = 1 + 3 * NLAYER;
#ifndef GEMM_ALIGN
#define GEMM_ALIGN true
#endif
static_assert(GEMM_ALIGN, "the q/k-norm exchange in the in-proj epilogue takes a workgroup barrier: both half-workgroups must be in their epilogues together");
#ifndef GEMM_SP2
#define GEMM_SP2 true
#endif
__global__ void __launch_bounds__(NTHR, 2) hymba_fwd(Args args) {
    extern __shared__ __attribute__((aligned(16))) unsigned char lds_raw[];
    Frame F;
    F.lds = (LAS unsigned char*)lds_raw; F.misc = (volatile LAS unsigned*)(F.lds + MISC_OFF);
    F.tid = threadIdx.x; F.lane = F.tid & 63; F.wave = __builtin_amdgcn_readfirstlane(F.tid >> 6); F.G = gridDim.x;
    F.kp = (KArgP)__builtin_amdgcn_kernarg_segment_ptr();
    if (F.tid < 64) F.misc[F.tid] = 0u;
    __syncthreads();
    XcdBarrier bar = xcd_barrier_post(KCTL + CW_BAR, F.misc);
    const int lo = args.ph_lo, hi = args.ph_hi;
#define IN(k) (lo <= (k) && (k) < hi)
#ifndef PROBE_BAR2
#define PROBE_BAR2 0
#endif
#define SEAM(k) do { if (IN(k) && IN((k) + 1)) { xcd_barrier(bar); if (PROBE_BAR2) xcd_barrier(bar); } } while (0)
#ifndef PROBE_DUP
#define PROBE_DUP 0
#endif
    if (IN(0)) { p0_prologue(F); if (PROBE_DUP & 16) p0_prologue(F); }
    SEAM(0);
    for (int l = 0; l < NLAYER; ++l) {
        const int pb = 1 + 3 * l;
        bf16_t* Pm = (bf16_t*)(KWS + WS_P); bf16_t* Y = (bf16_t*)(KWS + WS_YCAT);
        if (IN(pb)) {
            pg8::Gemm g{(const bf16_t*)(KWS + WS_HB), (const bf16_t*)(KWS + WS_WIN + l * SZ_WIN_L), 8192, DINP, DMODEL};
            {
                const int pmrow = 256 * (4 * ((int)blockIdx.x & 7) + (((int)blockIdx.x >> 3) & 3));
                LAS float* rtab = (LAS float*)(F.lds + MISC_OFF + 12288);
                int rt_ = threadIdx.x; asm volatile("" : "+v"(rt_));
                if (rt_ < 256) { const f32x4* sp = (const f32x4*)((const float*)(KWS + WS_SSQ) + (size_t)(pmrow + rt_) * 64); f32x4 t = sp[0];
#pragma unroll
                    for (int q = 1; q < 16; ++q) t += sp[q];
                    rtab[rt_] = __builtin_amdgcn_rsqf(((t[0] + t[1]) + (t[2] + t[3])) * (1.0f / 4096.0f) + 1e-6f); }
                __syncthreads();
            }
            pg8::EpiInProj E{(bf16_t*)(KWS + WS_P), (const LAS float*)(F.lds + MISC_OFF + 12288), (LAS float*)(F.lds + MISC_OFF + 4096), KIN(10) + l * 128, KIN(11) + l * 128, QSCALE};
            int parts = 2; asm volatile("" : "+s"(parts));
#pragma unroll 1
            for (int part = 0; part < parts; ++part) {
                pg8::XcdOrder S{part ? DINP / 256 : 32, (int)blockIdx.x, 1, part ? 4 : 0};
                pg8::gemm_phase<pg8::EpiInProj, pg8::XcdOrder, GEMM_ALIGN, GEMM_SP2>(F.lds, g, S, E);
                if (part == 0) publish_add(KCTL + CW_RDY + 64 * l);
            }
            { const int rem = (32 * 52) % F.G, v = (int)blockIdx.x - rem;
              for (int vv = v; v >= 0 && vv < 104; vv += F.G - rem) thin_inproj(F, l, vv);
              if (v >= 0 && v < 104) publish_add(KCTL + CW_THIN + 64 * l); }
            __syncthreads();
            prep_queue(F, l);
            if (l + 1 < NLAYER) conv_queue(F, l + 1, KCTL + CW_CONVQ + 64 * l);
        }
        SEAM(pb);
        if (IN(pb + 1)) {
            { pg8::Gemm g{(const bf16_t*)(KWS + WS_ALN), (const bf16_t*)(KWS + WS_WPW + l * SZ_WPW_L), MPAD, GWID, GWID};
              pg8::StaticOrder S; S.init(MPAD, GWID, F.G, (int)blockIdx.x);
              pg8::EpiPw E{Pm, Y};
              pg8::gemm_phase<pg8::EpiPw, pg8::StaticOrder, true, true>(F.lds, g, S, E);
              if (PROBE_DUP & 4) pg8::gemm_phase<pg8::EpiPw, pg8::StaticOrder, true, true>(F.lds, g, S, E); }
            { int kpool = 256; asm volatile("" : "+s"(kpool));
              pg8::Gemm g{(const bf16_t*)(KWS + WS_POOLED), (const bf16_t*)(KWS + WS_WPOOL + l * SZ_WPOOL_L), 4 * MPAD, 1024, kpool};
              pg8::PoolOrder S{124, (int)blockIdx.x >= 132 ? (int)blockIdx.x - 132 : 4096};
              pg8::EpiPool E{Pm, Y, KIN(13) + l * GWID};
              pg8::gemm_phase<pg8::EpiPool, pg8::PoolOrder, true, true>(F.lds, g, S, E);
              if (PROBE_DUP & 4) pg8::gemm_phase<pg8::EpiPool, pg8::PoolOrder, true, true>(F.lds, g, S, E); }
            __syncthreads();
            attn_phase(F, l);
            if (PROBE_DUP & 8) attn_phase(F, l + 4);
        }
        SEAM(pb + 1);
        if (IN(pb + 2)) {
            const bool last = (l == NLAYER - 1);
            thin_outproj(F, l, last);
            pg8::Gemm g{(const bf16_t*)Y, (const bf16_t*)(KWS + WS_WOUT + l * SZ_WOUT_L), 8192, DMODEL, DMODEL};
            pg8::XcdOrder S{DMODEL / 256, (int)blockIdx.x, 0, 0};
            pg8::EpiOutProj E{(bf16_t*)(KWS + WS_HB), (kargs(F)->out), 16, (float*)(KWS + WS_SSQ), last ? 1 : 0};
            int reps = ((PROBE_DUP & 32) && last) ? 2 : 1; asm volatile("" : "+s"(reps));
#pragma unroll 1
            for (int rep = 0; rep < reps; ++rep) pg8::gemm_phase<pg8::EpiOutProj, pg8::XcdOrder, GEMM_ALIGN, GEMM_SP2>(F.lds, g, S, E);
        }
        SEAM(pb + 2);
    }
#undef IN
#undef SEAM
}

extern "C" void kernel_launch(void* const* d_in, const int* in_sizes, int n_in, void* d_out, int out_size, void* d_ws, size_t ws_size, hipStream_t stream) {
    static int grid = 0;
    if (grid == 0) {
        if (n_in != 15 || ws_size < WS_END) { fprintf(stderr, "kernel_launch: expected 15 inputs and >= %zu bytes of workspace (got %d, %zu)\n", (size_t)WS_END, n_in, ws_size); grid = -1; return; }
        int dev = 0, cus = 0, per_cu = 0;
        if (hipGetDevice(&dev) != hipSuccess || hipDeviceGetAttribute(&cus, hipDeviceAttributeMultiprocessorCount, dev) != hipSuccess) { grid = -1; return; }
        if (hipFuncSetAttribute((const void*)hymba_fwd, hipFuncAttributeMaxDynamicSharedMemorySize, LDS_BYTES) != hipSuccess) { fprintf(stderr, "kernel_launch: hipFuncSetAttribute failed\n"); grid = -1; return; }
        if (hipOccupancyMaxActiveBlocksPerMultiprocessor(&per_cu, (const void*)hymba_fwd, NTHR, LDS_BYTES) != hipSuccess || per_cu < 1) { fprintf(stderr, "kernel_launch: occupancy query says %d blocks per CU\n", per_cu); per_cu = 1; }
        (void)hipGetLastError();
        grid = cus;
        if (cus != 256) fprintf(stderr, "kernel_launch: built for 256 CUs (8 XCDs x 32); found %d: the GEMM unit order assumes a grid of 256\n", cus);
    }
    if (grid < 0) return;
    (void)hipMemsetAsync((char*)d_ws + WS_CTL, 0, CTL_BYTES, stream);
    Args a{};
    for (int i = 0; i < 15; ++i) a.in[i] = (const float*)d_in[i];
    a.out = (float*)d_out; a.ws = (unsigned char*)d_ws;
#if MK_N_LAUNCHES == 1
    a.ph_lo = 0; a.ph_hi = N_PHASES;
    hipLaunchKernelGGL(hymba_fwd, dim3(grid), dim3(NTHR), LDS_BYTES, stream, a);
#else
    for (int p = 0; p < N_PHASES; ++p) { a.ph_lo = p; a.ph_hi = p + 1; hipLaunchKernelGGL(hymba_fwd, dim3(grid), dim3(NTHR), LDS_BYTES, stream, a); }
#endif
    (void)in_sizes; (void)out_size;
}
```
